# Optimizing an MI355X kernel written in HIP

```python
import math
import jax, jax.numpy as jnp
from jax import lax
import numpy as np

D_MODEL = 1024
BATCH = 8
SEQ = 4096
DEPTH = 1

D_MIX = D_MODEL
HEAD_DIM = 64
ATTN_HEADS = (D_MIX // 2) // HEAD_DIM
ATTN_DIM = ATTN_HEADS * HEAD_DIM
CONV_DIM = D_MIX - ATTN_DIM
CONV_K = 3
IDX_HEADS = 8
IDX_DIM = 64
IDX_SCALE = (IDX_DIM ** -0.5) * (IDX_HEADS ** -0.5)
TOPK_KEYS_MAX = 256
QUERY_BLOCK = 128
ROPE_THETA = 500000.0
ROPE_DIM = HEAD_DIM // 4
N_EXPERTS = 64
TOP_K_EXPERTS = 8
EXPERT_DIM = 256
SHARED_DIM = 256
ROUTED_SCALE = 2.5
DISPATCH_BLOCK = 128
EPS = 1e-6
IN_SPLITS = (CONV_DIM, CONV_DIM, CONV_DIM, ATTN_DIM, ATTN_DIM, ATTN_DIM,
             IDX_HEADS * IDX_DIM, IDX_DIM, IDX_HEADS)
IN_COLS = sum(IN_SPLITS)

kernel_name = "hymba_conv_dsa_moe_adaln_block"


def rms_norm(x, g):
    xf = x.astype(jnp.float32)
    y = xf * lax.rsqrt(jnp.mean(xf * xf, axis=-1, keepdims=True) + EPS)
    return y.astype(x.dtype) * g


def apply_partial_rope(x, positions):
    half = ROPE_DIM // 2
    inv_freq = ROPE_THETA ** (-jnp.arange(half, dtype=jnp.float32) / half)
    ang = positions.astype(jnp.float32)[..., None] * inv_freq
    ang = ang.reshape(ang.shape[:2] + (1,) * (x.ndim - 3) + (half,))
    cos, sin = jnp.cos(ang), jnp.sin(ang)
    x1 = x[..., :half].astype(jnp.float32)
    x2 = x[..., half:ROPE_DIM].astype(jnp.float32)
    rot = jnp.concatenate([x1 * cos - x2 * sin, x2 * cos + x1 * sin], axis=-1)
    return jnp.concatenate([rot.astype(x.dtype), x[..., ROPE_DIM:]], axis=-1)


def short_conv(u, w):
    up = jnp.pad(u, ((0, 0), (CONV_K - 1, 0), (0, 0)))
    return up[:, :-2] * w[0] + up[:, 1:-1] * w[1] + up[:, 2:] * w[2]


def dsa_attention(q, k, v, qi, ki, wi):
    B, S, H, Dh = q.shape
    n_sel = min(TOPK_KEYS_MAX, S // 4)
    n_blocks = S // QUERY_BLOCK
    key_pos = jnp.arange(S)

    def block(j):
        q0 = j * QUERY_BLOCK
        qb = lax.dynamic_slice_in_dim(q, q0, QUERY_BLOCK, axis=1)
        qib = lax.dynamic_slice_in_dim(qi, q0, QUERY_BLOCK, axis=1)
        wib = lax.dynamic_slice_in_dim(wi, q0, QUERY_BLOCK, axis=1)
        t_pos = q0 + jnp.arange(QUERY_BLOCK)
        rel = jax.nn.relu(jnp.einsum('bqhd,bsd->bqhs', qib, ki).astype(jnp.float32))
        score = jnp.einsum('bqhs,bqh->bqs', rel, wib.astype(jnp.float32)) * IDX_SCALE
        causal = key_pos[None, :] <= t_pos[:, None]
        score = jnp.where(causal[None], score, -jnp.inf)
        _, idx = lax.top_k(score, n_sel)
        valid = idx <= t_pos[None, :, None]
        flat = idx.reshape(B, QUERY_BLOCK * n_sel)
        ks = jax.vmap(lambda kb, ib: kb[ib])(k, flat).reshape(B, QUERY_BLOCK, n_sel, H, Dh)
        vs = jax.vmap(lambda vb, ib: vb[ib])(v, flat).reshape(B, QUERY_BLOCK, n_sel, H, Dh)
        s = jnp.einsum('bqhd,bqkhd->bhqk', qb, ks).astype(jnp.float32) * (Dh ** -0.5)
        s = jnp.where(valid[:, None], s, -jnp.inf)
        p = jax.nn.softmax(s, axis=-1).astype(vs.dtype)
        o = jnp.einsum('bhqk,bqkhd->bqhd', p, vs)
        return o.reshape(B, QUERY_BLOCK, H * Dh)

    out = lax.map(block, jnp.arange(n_blocks))
    return out.transpose(1, 0, 2, 3).reshape(B, S, H * Dh)


def swiglu(x, w1, w3, w2):
    return (jax.nn.silu(x @ w1) * (x @ w3)) @ w2


def moe(h, w_router, router_bias, w1, w3, w2, ws1, ws3, ws2):
    B, S, D = h.shape
    t = h.reshape(-1, D)
    n_tok = t.shape[0]
    scores = jax.nn.sigmoid((t @ w_router).astype(jnp.float32))
    _, eidx = lax.top_k(scores + router_bias.astype(jnp.float32), TOP_K_EXPERTS)
    g = jnp.take_along_axis(scores, eidx, axis=1)
    g = g / jnp.sum(g, axis=-1, keepdims=True) * ROUTED_SCALE
    n_pair = n_tok * TOP_K_EXPERTS
    flat_e = eidx.reshape(-1)
    flat_tok = jnp.arange(n_pair, dtype=jnp.int32) // TOP_K_EXPERTS
    flat_g = g.reshape(-1).astype(t.dtype)
    order = jnp.argsort(flat_e)
    se, stok, sg = flat_e[order], flat_tok[order], flat_g[order]
    counts = jnp.bincount(flat_e, length=N_EXPERTS)
    padded = (counts + DISPATCH_BLOCK - 1) // DISPATCH_BLOCK * DISPATCH_BLOCK
    start = jnp.cumsum(counts) - counts
    pend = jnp.cumsum(padded)
    pstart = pend - padded
    dest = pstart[se] + jnp.arange(n_pair) - start[se]
    rows = n_pair + N_EXPERTS * DISPATCH_BLOCK
    n_blk = rows // DISPATCH_BLOCK
    row_tok = jnp.zeros((rows,), jnp.int32).at[dest].set(stok)
    row_g = jnp.zeros((rows,), t.dtype).at[dest].set(sg)
    block_e = jnp.clip(jnp.searchsorted(pend, jnp.arange(n_blk) * DISPATCH_BLOCK, side='right'),
                       0, N_EXPERTS - 1)

    def expert_block(args):
        e, toks, gs = args
        xb = t[toks]
        return swiglu(xb, w1[e], w3[e], w2[e]) * gs[:, None]

    out = lax.map(expert_block, (block_e, row_tok.reshape(n_blk, DISPATCH_BLOCK),
                                 row_g.reshape(n_blk, DISPATCH_BLOCK)))
    routed = jax.ops.segment_sum(out.reshape(rows, D), row_tok, num_segments=n_tok)
    shared = swiglu(t, ws1, ws3, ws2)
    return (routed + shared).reshape(B, S, D)


def hybrid_layer(x, c, positions, norm1_g, norm2_g, w_ada, b_ada, w_in, conv_w,
                 q_norm_g, k_norm_g, kidx_norm_g, w_out, w_router, router_bias,
                 w1, w3, w2, ws1, ws3, ws2):
    B, S, D = x.shape
    ada = jax.nn.silu(c) @ w_ada + b_ada
    shift1, scale1, gate1, shift2, scale2, gate2 = [a[:, None, :] for a in jnp.split(ada, 6, axis=-1)]

    h = rms_norm(x, norm1_g) * (1 + scale1) + shift1
    proj = h @ w_in
    cuts = list(np.cumsum(IN_SPLITS)[:-1])
    xc, bg, cg, q, k, v, qi, ki, wi = jnp.split(proj, cuts, axis=-1)
    conv_out = bg * short_conv(cg * xc, conv_w)
    q = apply_partial_rope(rms_norm(q.reshape(B, S, ATTN_HEADS, HEAD_DIM), q_norm_g), positions)
    k = apply_partial_rope(rms_norm(k.reshape(B, S, ATTN_HEADS, HEAD_DIM), k_norm_g), positions)
    v = v.reshape(B, S, ATTN_HEADS, HEAD_DIM)
    qi = apply_partial_rope(qi.reshape(B, S, IDX_HEADS, IDX_DIM), positions)
    ki = apply_partial_rope(rms_norm(ki, kidx_norm_g), positions)
    attn_out = dsa_attention(q, k, v, qi, ki, wi)
    mix = jnp.concatenate([conv_out, attn_out], axis=-1) @ w_out
    x = x + gate1 * mix

    h2 = rms_norm(x, norm2_g) * (1 + scale2) + shift2
    x = x + gate2 * moe(h2, w_router, router_bias, w1, w3, w2, ws1, ws3, ws2)
    return x


def setup_inputs(seed: int = 0) -> dict:
    key = jax.random.key(seed)
    ks = jax.random.split(key, 24)
    f32 = jnp.float32
    L, D, E, F, Fs = DEPTH, D_MODEL, N_EXPERTS, EXPERT_DIM, SHARED_DIM

    def nrm(k, shape, scale):
        return jax.random.normal(k, shape, f32) * scale

    positions = (jax.random.randint(ks[2], (BATCH, 1), 0, 1024, dtype=jnp.int32)
                 + jnp.arange(SEQ, dtype=jnp.int32)[None, :])
    return {
        "x": nrm(ks[0], (BATCH, SEQ, D), 1.0),
        "c": nrm(ks[1], (BATCH, D), 1.0),
        "positions": positions,
        "norm1_g": 1.0 + nrm(ks[3], (L, D), 0.02),
        "norm2_g": 1.0 + nrm(ks[4], (L, D), 0.02),
        "w_ada": nrm(ks[5], (L, D, 6 * D), 0.5 * D ** -0.5),
        "b_ada": nrm(ks[6], (L, 6 * D), 0.02),
        "w_in": nrm(ks[7], (L, D, IN_COLS), D ** -0.5),
        "conv_w": nrm(ks[8], (L, CONV_K, CONV_DIM), CONV_K ** -0.5),
        "q_norm_g": 1.0 + nrm(ks[9], (L, HEAD_DIM), 0.02),
        "k_norm_g": 1.0 + nrm(ks[10], (L, HEAD_DIM), 0.02),
        "kidx_norm_g": 1.0 + nrm(ks[11], (L, IDX_DIM), 0.02),
        "w_out": nrm(ks[12], (L, D_MIX, D), D_MIX ** -0.5),
        "w_router": nrm(ks[13], (L, D, E), D ** -0.5),
        "router_bias": nrm(ks[14], (L, E), 0.01),
        "w1": nrm(ks[15], (L, E, D, F), D ** -0.5),
        "w3": nrm(ks[16], (L, E, D, F), D ** -0.5),
        "w2": nrm(ks[17], (L, E, F, D), F ** -0.5),
        "ws1": nrm(ks[18], (L, D, Fs), D ** -0.5),
        "ws3": nrm(ks[19], (L, D, Fs), D ** -0.5),
        "ws2": nrm(ks[20], (L, Fs, D), Fs ** -0.5),
    }


def reference(x, c, positions, norm1_g, norm2_g, w_ada, b_ada, w_in, conv_w,
              q_norm_g, k_norm_g, kidx_norm_g, w_out, w_router, router_bias,
              w1, w3, w2, ws1, ws3, ws2):
    for l in range(DEPTH):
        x = hybrid_layer(x, c, positions, norm1_g[l], norm2_g[l], w_ada[l], b_ada[l],
                         w_in[l], conv_w[l], q_norm_g[l], k_norm_g[l], kidx_norm_g[l],
                         w_out[l], w_router[l], router_bias[l], w1[l], w3[l], w2[l],
                         ws1[l], ws3[l], ws2[l])
    return x
```

```cpp
#include <hip/hip_runtime.h>
#include <cstdint>
#include <cstdio>

#define LAS __attribute__((address_space(3)))
#define GAS __attribute__((address_space(1)))
typedef unsigned short bf16_t;
typedef short bf16x8 __attribute__((ext_vector_type(8)));
typedef short s16x4 __attribute__((ext_vector_type(4)));
typedef float f32x2 __attribute__((ext_vector_type(2)));
typedef float f32x4 __attribute__((ext_vector_type(4)));
typedef float f32x16 __attribute__((ext_vector_type(16)));
typedef unsigned u32x2 __attribute__((ext_vector_type(2)));
typedef unsigned u32x4 __attribute__((ext_vector_type(4)));
typedef __bf16 bf16x2_t __attribute__((ext_vector_type(2)));

constexpr int NB = 8, SEQ = 4096, NTOK = NB * SEQ, DM = 1024;
constexpr int NIN = 3840;
constexpr int NEXP = 64;
constexpr float EPS = 1e-6f;
constexpr float LOG2E = 1.4426950408889634f;
constexpr float QSCALE = 0.125f * LOG2E;
constexpr int PAIRCAP = 32768;
constexpr int NWAVES = 8, NTHR = 512;

constexpr size_t MiB = 1u << 20;
constexpr size_t WS_CTL = 0, CTL_ZERO_BYTES = 1 * MiB;
constexpr size_t WS_ADA = 1 * MiB;
constexpr size_t WS_W2 = 2 * MiB;
constexpr size_t WS_PAIR = 35 * MiB;
constexpr size_t WS_GATE = 43 * MiB;
constexpr size_t WS_INV = 44 * MiB;
constexpr size_t WS_HID = 52 * MiB;
constexpr size_t WS_Y = 204 * MiB;
constexpr size_t WS_U = 35 * MiB, WS_BG = 67 * MiB, WS_Q = 99 * MiB, WS_K = 131 * MiB, WS_V = 163 * MiB;
constexpr size_t WS_XN = 204 * MiB;
constexpr size_t WS_W13 = 268 * MiB;
constexpr size_t WS_QI = 333 * MiB, WS_KI = 365 * MiB, WS_WI = 369 * MiB, WS_MASK = 370 * MiB, WS_MIX = 386 * MiB;
constexpr size_t WS_LOG = 450 * MiB;
constexpr size_t WS_ROPE = 458 * MiB;
constexpr size_t WS_BTIN = 460 * MiB;
constexpr size_t WS_BTOUT = 468 * MiB;
constexpr size_t WS_WRT = 470 * MiB;
constexpr size_t WS_END = 508 * MiB;
constexpr int SH_TILES = 128;
constexpr int CW_BAR = 4096, CW_CNT = 8192;
constexpr int RING_BYTES = 131072, MISC_OFF = RING_BYTES, MISC_BYTES = 16384, HIST_OFF = MISC_OFF + MISC_BYTES, LDS_BYTES = 163840;
constexpr int MW_TP = 32, MW_CNT = 128, MW_LCNT = 192, MW_BASE = 256, MW_TPX = 320;

__device__ __forceinline__ unsigned pk2(float lo, float hi) { f32x2 v = {lo, hi}; bf16x2_t b = __builtin_convertvector(v, bf16x2_t); return __builtin_bit_cast(unsigned, b); }
__device__ __forceinline__ float bf2f(unsigned short h) { return __uint_as_float((unsigned)h << 16); }
__device__ __forceinline__ float wave_sum(float v) {
#pragma unroll
    for (int o = 1; o < 64; o <<= 1) v += __shfl_xor(v, o);
    return v;
}
__device__ __forceinline__ float wave_max(float v) {
#pragma unroll
    for (int o = 1; o < 64; o <<= 1) v = fmaxf(v, __shfl_xor(v, o));
    return v;
}
__device__ __forceinline__ int wave_sum_i(int v) {
    v += __builtin_amdgcn_update_dpp(0, v, 0xB1, 0xf, 0xf, false);
    v += __builtin_amdgcn_update_dpp(0, v, 0x4E, 0xf, 0xf, false);
    v += __builtin_amdgcn_update_dpp(0, v, 0x141, 0xf, 0xf, false);
    v += __builtin_amdgcn_update_dpp(0, v, 0x140, 0xf, 0xf, false);
    return __builtin_amdgcn_readlane(v, 0) + __builtin_amdgcn_readlane(v, 16) + __builtin_amdgcn_readlane(v, 32) + __builtin_amdgcn_readlane(v, 48);
}
__device__ __forceinline__ float silu_f(float x) { return x / (1.0f + __expf(-x)); }

__host__ __device__ __forceinline__ int uc_head(int hh, int d) { return 128 * ((d >> 3) & 1) + 32 * hh + 8 * (d >> 4) + (d & 7); }
__host__ __device__ __forceinline__ int in_dest_row(int c) {
    if (c < 512) return 256 * (c >> 7) + (c & 127);
    if (c < 1024) { const int x = c - 512; return 256 * (4 + (x >> 8)) + (x & 255); }
    if (c < 1536) { const int x = c - 1024; return 256 * (x >> 7) + 128 + (x & 127); }
    if (c < 2048) { const int x = c - 1536; return 256 * (6 + (x >> 8)) + uc_head((x >> 6) & 3, x & 63); }
    if (c < 2560) { const int x = c - 2048; return 256 * (8 + (x >> 8)) + uc_head((x >> 6) & 3, x & 63); }
    if (c < 3072) { const int x = c - 2560; return 256 * (10 + (x >> 8)) + (x & 255); }
    if (c < 3584) { const int x = c - 3072; return 256 * (12 + (x >> 8)) + uc_head((x >> 6) & 3, x & 63); }
    if (c < 3648) return 256 * 14 + uc_head(0, c - 3584);
    return 256 * 14 + uc_head(1, c - 3648);
}
__host__ __device__ __forceinline__ bool in_row_has_src(int r) {
    if (r < 256 * 14) return true;
    const int uc = r & 255, bj = uc >> 7, wc = (uc >> 5) & 3, fq = (uc >> 3) & 3, d = 16 * fq + 8 * bj + (uc & 7);
    if (wc == 0) return true;
    if (wc == 1) return d < 8;
    return false;
}

namespace g8 {
constexpr int BM = 256, BK = 64, HALF = 128, HTB = HALF * BK * 2;
__host__ __device__ __forceinline__ int lds_byte(int r, int c) { const int st = (r >> 4) * 2 + (c >> 5), rr = r & 15, cc = c & 31, ob = rr * 64 + cc * 2; return st * 1024 + (ob ^ (((ob >> 9) & 1) << 5)); }
__host__ __device__ __forceinline__ void stage_rc(int b, int& R, int& C) { const int st = b / 1024, sb = b % 1024, swz = sb ^ (((sb >> 9) & 1) << 5); R = (st >> 1) * 16 + swz / 64; C = (st & 1) * 32 + (swz % 64) / 2; }
__host__ __device__ __forceinline__ int perm32(int rho) { const int n = rho >> 4, i = rho & 15; return 8 * (i >> 2) + 4 * n + (i & 3); }
struct Unit { int pm, pn, e, j; };
typedef f32x4 Acc[2][2][4][2];

constexpr int NXCD = 8, WGM = 8;
struct StaticOrder {
    int nM, nN, nwg, G, c;
    __device__ void init(int M, int N, int G_, int c_) { nM = M / BM; nN = N / BM; nwg = nM * nN; G = G_; c = c_; }
    __device__ bool next(int i, Unit& u) const {
        const long L = (long)i * G + c; if (L >= nwg) return false;
        int wgid = (int)L; { const int q = nwg / NXCD, r = nwg % NXCD, xcd = wgid % NXCD, off = wgid / NXCD; wgid = (xcd < r ? xcd * (q + 1) : r * (q + 1) + (xcd - r) * q) + off; }
        const int nig = WGM * nN, gid = wgid / nig, fm = gid * WGM, gsz = (nM - fm) < WGM ? (nM - fm) : WGM;
        u.pm = fm + ((wgid % nig) % gsz); u.pn = (wgid % nig) / gsz; u.e = 0; u.j = 0; return true;
    }
};

#define G8_SA(b, h) (((b) * 2 + (h)) * g8::HTB)
#define G8_SB(b, h) ((4 + (b) * 2 + (h)) * g8::HTB)
#define G8_STAGE(bufoff, gbase, voff) do { _Pragma("unroll") for (int _i = 0; _i < 2; ++_i) \
        __builtin_amdgcn_global_load_lds((const unsigned*)((const char*)(gbase) + (voff)[_i]), (LAS unsigned*)(lds + (bufoff) + ldsw + _i * 8192), 16, 0, 0); } while (0)
#define G8_LDA(dst, b, h) do { _Pragma("unroll") for (int m = 0; m < 4; ++m) _Pragma("unroll") for (int k = 0; k < 2; ++k) dst[m][k] = *(const LAS bf16x8*)(lds + G8_SA(b, h) + aoff + m * 2048 + k * 1024); } while (0)
#define G8_LDB(dst, b, h) do { _Pragma("unroll") for (int n = 0; n < 2; ++n) _Pragma("unroll") for (int k = 0; k < 2; ++k) dst[n][k] = *(const LAS bf16x8*)(lds + G8_SB(b, h) + boff + n * 2048 + k * 1024); } while (0)
#define G8_MMA(ai, bj, At, Bt) do { __builtin_amdgcn_s_setprio(1); _Pragma("unroll") for (int m = 0; m < 4; ++m) _Pragma("unroll") for (int n = 0; n < 2; ++n) _Pragma("unroll") for (int k = 0; k < 2; ++k) \
        acc[ai][bj][m][n] = __builtin_amdgcn_mfma_f32_16x16x32_bf16(Bt[n][k], At[m][k], acc[ai][bj][m][n], 0, 0, 0); __builtin_amdgcn_s_setprio(0); } while (0)
#define G8_WAIT_V(n) asm volatile("s_waitcnt vmcnt(" #n ")" ::: "memory")
#define G8_WAIT_VI(n) asm volatile("s_waitcnt vmcnt(%0)" :: "i"(n) : "memory")
#define G8_WAIT_L(n) asm volatile("s_waitcnt lgkmcnt(" #n ")" ::: "memory")
#define G8_BAR __builtin_amdgcn_s_barrier()
#define G8_SCHED __builtin_amdgcn_sched_barrier(0)

template <class P>
__device__ __forceinline__ void gemm_run(LAS unsigned char* lds, const int tid, const P& p) {
    const int wid = __builtin_amdgcn_readfirstlane(tid >> 6), lane = tid & 63, wr = wid >> 2, wc = wid & 3, fr = lane & 15, fq = lane >> 4;
    constexpr int K = P::K, nt = K / BK;
    int R0, C0; stage_rc(tid * 16, R0, C0);
    unsigned voffB[2];
#pragma unroll
    for (int i = 0; i < 2; ++i) { const int R = R0 + 64 * i, Rb = (R & ~31) + perm32(R & 31); voffB[i] = (unsigned)(Rb * K + C0) * 2u; }
    const unsigned colA = (unsigned)C0 * 2u;
    constexpr size_t kstep = (size_t)(BK * 2), hstepB = (size_t)HALF * K * 2;
    const unsigned ldsw = (unsigned)wid * 1024u;
    const int aoff = lds_byte(wr * 64 + fr, fq * 8), boff = lds_byte(wc * 32 + fr, fq * 8);
    const char* const Ab = p.abase();
    Unit cur, nxt; int ui = 0;
    if (!p.next(0, cur)) return;
    Acc acc;
#pragma unroll
    for (int a = 0; a < 2; ++a)
#pragma unroll
        for (int b = 0; b < 2; ++b)
#pragma unroll
            for (int m = 0; m < 4; ++m)
#pragma unroll
                for (int n = 0; n < 2; ++n) acc[a][b][m][n] = (f32x4){0.f, 0.f, 0.f, 0.f};
    bf16x8 At[4][2], B0[2][2], B1[2][2];
    unsigned roC[2][2], roN[2][2];
    p.arows(cur, R0, roC);
#pragma unroll
    for (int h = 0; h < 2; ++h)
#pragma unroll
        for (int i = 0; i < 2; ++i) roC[h][i] += colA;
    const char* cB = p.bbase(cur);
    G8_STAGE(G8_SB(0, 0), cB, voffB); G8_STAGE(G8_SB(0, 1), cB + hstepB, voffB); G8_STAGE(G8_SA(0, 0), Ab, roC[0]); G8_STAGE(G8_SA(0, 1), Ab, roC[1]);
    if (wr == 1) G8_BAR;
    G8_WAIT_V(2); G8_BAR;
    G8_STAGE(G8_SB(1, 0), cB + kstep, voffB); G8_STAGE(G8_SA(1, 0), Ab + kstep, roC[0]); G8_STAGE(G8_SB(1, 1), cB + hstepB + kstep, voffB);
    G8_WAIT_V(6); G8_BAR;
    for (;;) {
        const bool has_next = p.next(ui + 1, nxt);
        const char* nB = cB;
        if (has_next) {
            p.arows(nxt, R0, roN);
#pragma unroll
            for (int h = 0; h < 2; ++h)
#pragma unroll
                for (int i = 0; i < 2; ++i) roN[h][i] += colA;
            nB = p.bbase(nxt);
        } else {
#pragma unroll
            for (int h = 0; h < 2; ++h)
#pragma unroll
                for (int i = 0; i < 2; ++i) roN[h][i] = roC[h][i];
        }
#pragma unroll 1
        for (int t = 0; t < nt; t += 2) {
            const bool last = (t == nt - 2);
            const char* a1 = Ab + (size_t)(t + 1) * kstep;
            const char* a2 = last ? Ab : Ab + (size_t)(t + 2) * kstep; const char* b2 = last ? nB : cB + (size_t)(t + 2) * kstep;
            const char* a3 = a2 + kstep; const char* b3 = b2 + kstep;
            unsigned r2[2][2];
#pragma unroll
            for (int h = 0; h < 2; ++h)
#pragma unroll
                for (int i = 0; i < 2; ++i) r2[h][i] = last ? roN[h][i] : roC[h][i];
            unsigned rc1[2] = {roC[1][0], roC[1][1]};
            asm volatile("" : "+v"(r2[0][0]), "+v"(r2[0][1]), "+v"(r2[1][0]), "+v"(r2[1][1]), "+v"(rc1[0]), "+v"(rc1[1]));
            const bool after_epi = (P::EPI_STORES > 0) && (t == 0) && (ui > 0);
            G8_LDB(B0, 0, 0); G8_LDB(B1, 0, 1); G8_SCHED; G8_LDA(At, 0, 0); G8_STAGE(G8_SA(1, 1), a1, rc1);
            if (after_epi) G8_WAIT_VI(8 + P::EPI_STORES); else G8_WAIT_V(8);
            G8_WAIT_L(0); G8_BAR; G8_MMA(0, 0, At, B0); G8_MMA(0, 1, At, B1); G8_BAR; G8_SCHED;
            G8_LDA(At, 0, 1); G8_STAGE(G8_SB(0, 0), b2, voffB); G8_STAGE(G8_SB(0, 1), b2 + hstepB, voffB); G8_STAGE(G8_SA(0, 0), a2, r2[0]);
            if (after_epi) G8_WAIT_VI(8 + P::EPI_STORES); else G8_WAIT_V(8);
            G8_WAIT_L(0); G8_BAR; G8_MMA(1, 0, At, B0); G8_MMA(1, 1, At, B1); G8_BAR; G8_SCHED;
            G8_LDB(B0, 1, 0); G8_LDB(B1, 1, 1); G8_SCHED; G8_LDA(At, 1, 0); G8_STAGE(G8_SA(0, 1), a2, r2[1]);
            G8_WAIT_V(8); G8_WAIT_L(0); G8_BAR; G8_MMA(0, 0, At, B0); G8_MMA(0, 1, At, B1); G8_BAR; G8_SCHED;
            G8_LDA(At, 1, 1); G8_STAGE(G8_SB(1, 0), b3, voffB); G8_STAGE(G8_SB(1, 1), b3 + hstepB, voffB); G8_STAGE(G8_SA(1, 0), a3, r2[0]);
            G8_WAIT_V(8); G8_WAIT_L(0); G8_BAR; G8_MMA(1, 0, At, B0); G8_MMA(1, 1, At, B1); G8_BAR; G8_SCHED;
        }
        if (wr == 0) G8_BAR;
        p.epi(acc, cur, wr, wc, fr, fq);
        if (!has_next) break;
#pragma unroll
        for (int a = 0; a < 2; ++a)
#pragma unroll
            for (int b = 0; b < 2; ++b)
#pragma unroll
                for (int m = 0; m < 4; ++m)
#pragma unroll
                    for (int n = 0; n < 2; ++n) acc[a][b][m][n] = (f32x4){0.f, 0.f, 0.f, 0.f};
        cur = nxt; cB = nB; ++ui;
#pragma unroll
        for (int h = 0; h < 2; ++h)
#pragma unroll
            for (int i = 0; i < 2; ++i) roC[h][i] = roN[h][i];
        if (wr == 1) G8_BAR;
    }
    G8_WAIT_V(0);
    G8_BAR;
}
}

#define XB_TMO      128
#define XB_XCNT(j)  (256  + 64 * (j))
#define XB_XSUB(j)  (1280 + 64 * (j))
#define XB_XGEN(j)  (2304 + 64 * (j))
#define XB_TOP      3328
#define XB_TOPGEN   3392
#define XCD_BAR_WORDS 3456
#define XB_SPIN_CAP (1u << 18)
__device__ __forceinline__ unsigned xb_ld(unsigned* p)              { return __hip_atomic_load(p, __ATOMIC_RELAXED, __HIP_MEMORY_SCOPE_AGENT); }
__device__ __forceinline__ unsigned xb_add(unsigned* p, unsigned v) { return __hip_atomic_fetch_add(p, v, __ATOMIC_RELAXED, __HIP_MEMORY_SCOPE_AGENT); }
__device__ __forceinline__ unsigned xb_xcc_id() { return (unsigned)__builtin_amdgcn_s_getreg((3 << 11) | 20) & 0xFu; }
#define XB_SPIN(cond, bar) do { unsigned _sp = 0; while (cond) { __builtin_amdgcn_s_sleep(1); \
    if ((++_sp & 255u) == 0u) { if (xb_ld(&(bar)[XB_TMO])) break; if (_sp > XB_SPIN_CAP) { atomicAdd(&(bar)[XB_TMO], 1u); break; } } } } while (0)
struct XcdBarrier { unsigned* bar; unsigned x; volatile LAS unsigned* st; };
__device__ __forceinline__ XcdBarrier xcd_barrier_post(unsigned* bar, volatile LAS unsigned* st) {
    XcdBarrier b; b.bar = bar; b.x = xb_xcc_id(); b.st = st;
    if (threadIdx.x == 0) (void)xb_add(&bar[XB_XCNT(b.x)], 1u);
    return b;
}
__device__ __forceinline__ void xcd_barrier_complete(unsigned* bar, unsigned x, unsigned& nloc, unsigned& nx) {
    const unsigned G = gridDim.x * gridDim.y * gridDim.z;
    unsigned sum, cnt, mine, sp = 0u;
    for (;;) {
        sum = 0u; cnt = 0u; mine = 0u;
#pragma unroll
        for (unsigned j = 0; j < 16; ++j) { const unsigned c = xb_ld(&bar[XB_XCNT(j)]); sum += c; cnt += (c > 0u) ? 1u : 0u; mine = (j == x) ? c : mine; }
        if (sum == G) break;
        __builtin_amdgcn_s_sleep(1);
        if ((++sp & 255u) == 0u) { if (xb_ld(&bar[XB_TMO])) break; if (sp > XB_SPIN_CAP) { atomicAdd(&bar[XB_TMO], 1u); break; } }
    }
    nloc = mine > 0u ? mine : 1u; nx = cnt > 0u ? cnt : 1u;
}
__device__ __forceinline__ void xcd_barrier(const XcdBarrier& b) {
    asm volatile("s_waitcnt vmcnt(0)" ::: "memory");
    __syncthreads();
    if (threadIdx.x == 0) {
        unsigned* bar = b.bar;
        __builtin_amdgcn_s_waitcnt(0);
        unsigned nloc = b.st[0], nx = b.st[1];
        if (nloc == 0u) { xcd_barrier_complete(bar, b.x, nloc, nx); b.st[0] = nloc; b.st[1] = nx; }
        const unsigned old = xb_add(&bar[XB_XSUB(b.x)], 1u);
        const unsigned gen = old / nloc;
        if (old + 1u == (gen + 1u) * nloc) {
            __builtin_amdgcn_fence(__ATOMIC_RELEASE, "agent");
            asm volatile("s_waitcnt vmcnt(0)" ::: "memory");
            const unsigned og = xb_add(&bar[XB_TOP], 1u);
            const unsigned tg = og / nx;
            if (og + 1u == (tg + 1u) * nx) xb_add(&bar[XB_TOPGEN], 1u);
            else XB_SPIN(xb_ld(&bar[XB_TOPGEN]) == tg, bar);
            __builtin_amdgcn_fence(__ATOMIC_ACQUIRE, "agent");
            xb_add(&bar[XB_XGEN(b.x)], 1u);
            asm volatile("s_waitcnt vmcnt(0)" ::: "memory");
        } else {
            XB_SPIN(xb_ld(&bar[XB_XGEN(b.x)]) == gen, bar);
            __builtin_amdgcn_fence(__ATOMIC_ACQUIRE, "agent");
            asm volatile("s_waitcnt vmcnt(0)" ::: "memory");
        }
    }
    __syncthreads();
}

struct Args {
    const float* x; const float* c; const int* pos; const float* norm1_g; const float* norm2_g; const float* w_ada; const float* b_ada; const float* w_in;
    const float* conv_w; const float* q_g; const float* k_g; const float* ki_g; const float* w_out; const float* w_router; const float* router_bias;
    const float* w1; const float* w3; const float* w2; const float* ws1; const float* ws3; const float* ws2;
    float* out; unsigned char* ws;
};
typedef const __attribute__((address_space(4))) Args* ArgsP;
struct Frame {
    LAS unsigned char* lds; volatile LAS unsigned* MISC;
    int tid, lane, wave, G, bx;
    unsigned char* ws;
};
__device__ __forceinline__ ArgsP refresh(Frame& F) {
    int t = threadIdx.x; asm volatile("" : "+v"(t)); F.tid = t; F.lane = t & 63; F.wave = __builtin_amdgcn_readfirstlane(t >> 6);
    int b = blockIdx.x; asm volatile("" : "+s"(b)); F.bx = b;
    ArgsP p = (ArgsP)__builtin_amdgcn_kernarg_segment_ptr(); asm volatile("" : "+s"(p));
    F.ws = p->ws; return p;
}
#define WSP(T, off) ((T*)(F.ws + (off)))

template <class Map>
__device__ __forceinline__ void tr_item(const float* W, int N, int k0, int n0, bf16_t* WT, int ldt, LAS float* scr, int lane, Map map) {
    const int r = lane >> 3, c4 = (lane & 7) * 4;
    f32x4 v[8];
#pragma unroll
    for (int u = 0; u < 8; ++u) v[u] = (n0 + c4 < N) ? *(const f32x4*)(W + (size_t)(k0 + 8 * u + r) * N + n0 + c4) : (f32x4){0.f, 0.f, 0.f, 0.f};
#pragma unroll
    for (int u = 0; u < 8; ++u) { LAS float* d = scr + (8 * u + r) * 33 + c4; d[0] = v[u][0]; d[1] = v[u][1]; d[2] = v[u][2]; d[3] = v[u][3]; }
    asm volatile("s_waitcnt lgkmcnt(0)" ::: "memory");
    const int c = lane & 7;
#pragma unroll
    for (int j = 0; j < 4; ++j) {
        const int nl = (lane >> 3) + 8 * j, n = n0 + nl;
        if (n < N) {
            const LAS float* s = scr + (8 * c) * 33 + nl;
            u32x4 o; o.x = pk2(s[0 * 33], s[1 * 33]); o.y = pk2(s[2 * 33], s[3 * 33]); o.z = pk2(s[4 * 33], s[5 * 33]); o.w = pk2(s[6 * 33], s[7 * 33]);
            *(u32x4*)(WT + (size_t)map(n) * ldt + k0 + 8 * c) = o;
        }
    }
    asm volatile("s_waitcnt lgkmcnt(0)" ::: "memory");
}

__device__ __forceinline__ void phase0a(Frame& F, ArgsP ap) {
    struct { const float *c, *w_ada, *b_ada, *w_in, *w_out, *w_router, *w1, *w3, *w2, *ws1, *ws3, *ws2; const int* pos; } a;
    a.c = ap->c; a.w_ada = ap->w_ada; a.b_ada = ap->b_ada; a.w_in = ap->w_in; a.w_out = ap->w_out; a.w_router = ap->w_router; a.w1 = ap->w1; a.w3 = ap->w3; a.w2 = ap->w2;
    a.ws1 = ap->ws1; a.ws3 = ap->ws3; a.ws2 = ap->ws2; a.pos = ap->pos;
    const int gw = F.bx * NWAVES + F.wave, NGW = F.G * NWAVES, lane = F.lane;
    for (int it = gw; it < 2048; it += NGW) {
        const int col0 = 3 * it;
        float w[16][3];
#pragma unroll
        for (int i = 0; i < 16; ++i)
#pragma unroll
            for (int j = 0; j < 3; ++j) w[i][j] = a.w_ada[(size_t)(lane + 64 * i) * 6144 + col0 + j];
        float* ada = WSP(float, WS_ADA);
        for (int b = 0; b < NB; ++b) {
            float s0 = 0.f, s1 = 0.f, s2 = 0.f;
#pragma unroll
            for (int i = 0; i < 16; ++i) { const float cv = silu_f(a.c[b * DM + lane + 64 * i]); s0 += cv * w[i][0]; s1 += cv * w[i][1]; s2 += cv * w[i][2]; }
            s0 = wave_sum(s0); s1 = wave_sum(s1); s2 = wave_sum(s2);
            if (lane == 0) { ada[b * 6144 + col0] = s0 + a.b_ada[col0]; ada[b * 6144 + col0 + 1] = s1 + a.b_ada[col0 + 1]; ada[b * 6144 + col0 + 2] = s2 + a.b_ada[col0 + 2]; }
        }
    }
    LAS float* scr = (LAS float*)(F.lds + F.wave * 16384);
    bf16_t* btin = WSP(bf16_t, WS_BTIN); bf16_t* btout = WSP(bf16_t, WS_BTOUT); bf16_t* wrt = WSP(bf16_t, WS_WRT); bf16_t* w13 = WSP(bf16_t, WS_W13); bf16_t* w2t = WSP(bf16_t, WS_W2);
    for (int it = gw; it < 16 * 115; it += NGW) tr_item(a.w_in, 3656, 64 * (it / 115), 32 * (it % 115), btin, 1024, scr, lane, [](int n) { return in_dest_row(n); });
    for (int it = gw; it < 16 * 32; it += NGW) tr_item(a.w_out, 1024, 64 * (it / 32), 32 * (it % 32), btout, 1024, scr, lane, [](int n) { return n; });
    for (int it = gw; it < 16 * 2; it += NGW) tr_item(a.w_router, 64, 64 * (it / 2), 32 * (it % 2), wrt, 1024, scr, lane, [](int n) { return n; });
    for (int it = gw; it < 65 * 128; it += NGW) {
        const int e = it >> 7, r = it & 127, k0 = 64 * (r >> 3), n0 = 32 * (r & 7);
        const float* s1 = (e < 64) ? a.w1 + (size_t)e * 262144 : a.ws1; const float* s3 = (e < 64) ? a.w3 + (size_t)e * 262144 : a.ws3;
        tr_item(s1, 256, k0, n0, w13, 1024, scr, lane, [e](int n) { return e * 512 + 256 * (n >> 7) + (n & 127); });
        tr_item(s3, 256, k0, n0, w13, 1024, scr, lane, [e](int n) { return e * 512 + 256 * (n >> 7) + 128 + (n & 127); });
    }
    for (int it = gw; it < 65 * 128; it += NGW) {
        const int e = it >> 7, r = it & 127, k0 = 64 * (r >> 5), n0 = 32 * (r & 31);
        const float* s2 = (e < 64) ? a.w2 + (size_t)e * 262144 : a.ws2;
        tr_item(s2, 1024, k0, n0, w2t, 256, scr, lane, [e](int n) { return e * 1024 + (n & ~255) + 128 * ((n >> 3) & 1) + 32 * ((n >> 6) & 3) + 8 * ((n >> 4) & 3) + (n & 7); });
    }
    for (int it = gw; it < 256 + 192; it += NGW) {
        bf16_t* row = nullptr;
        if (it < 256) { const int r = 256 * 14 + it; if (!in_row_has_src(r)) row = btin + (size_t)r * 1024; }
        else row = wrt + (size_t)(64 + it - 256) * 1024;
        if (row) { u32x4 z = {0u, 0u, 0u, 0u}; *(u32x4*)(row + lane * 8) = z; *(u32x4*)(row + 512 + lane * 8) = z; }
    }
    {
        const float invf[8] = {1.0f, 0.1939227432012558f, 0.03760603070259094f, 0.007292664609849453f, 0.0014142135623842478f, 0.00027424818836152554f, 5.3182957344688475e-05f, 1.0313385246263351e-05f};
        float* rope = WSP(float, WS_ROPE);
        for (int it = F.bx * NTHR + F.tid; it < NTOK * 8; it += F.G * NTHR) {
            const int tok = it >> 3, i = it & 7;
            float fr = 1.0f;
#pragma unroll
            for (int k = 0; k < 8; ++k) fr = (i == k) ? invf[k] : fr;
            const float ang = (float)a.pos[tok] * fr;
            const float kk = rintf(ang * 0.15915494309189535f);
            float r = fmaf(-kk, 6.2831854820251465f, ang); r = fmaf(-kk, -1.7484555314695172e-07f, r);
            rope[tok * 16 + i] = cosf(r); rope[tok * 16 + 8 + i] = sinf(r);
        }
    }
}

__device__ __forceinline__ void modnorm_rows(Frame& F, const float* X, const float* g, int ada_shift_off, bf16_t* O) {
    const int gw = F.bx * NWAVES + F.wave, NGW = F.G * NWAVES, lane = F.lane;
    const float* ada = WSP(float, WS_ADA);
    for (int m = gw; m < NTOK; m += 2 * NGW) {
        const int m2 = m + NGW;
        const f32x4* xr = (const f32x4*)(X + (size_t)m * DM) + lane; const f32x4* xr2 = (const f32x4*)(X + (size_t)m2 * DM) + lane;
        f32x4 v[4], w[4]; float s = 0.f, s2 = 0.f;
#pragma unroll
        for (int j = 0; j < 4; ++j) { v[j] = xr[64 * j]; w[j] = xr2[64 * j]; }
#pragma unroll
        for (int j = 0; j < 4; ++j) { s += (v[j].x * v[j].x + v[j].y * v[j].y) + (v[j].z * v[j].z + v[j].w * v[j].w); s2 += (w[j].x * w[j].x + w[j].y * w[j].y) + (w[j].z * w[j].z + w[j].w * w[j].w); }
        const float rstd = rsqrtf(wave_sum(s) * (1.f / DM) + EPS), rstd2 = rsqrtf(wave_sum(s2) * (1.f / DM) + EPS);
        u32x2* o8 = (u32x2*)(O + (size_t)m * DM) + lane; u32x2* o82 = (u32x2*)(O + (size_t)m2 * DM) + lane;
        const float* ab = ada + (m >> 12) * 6144 + ada_shift_off; const float* ab2 = ada + (m2 >> 12) * 6144 + ada_shift_off;
#pragma unroll
        for (int j = 0; j < 4; ++j) {
            const f32x4 gg = ((const f32x4*)g)[lane + 64 * j];
            const f32x4 sh = ((const f32x4*)ab)[lane + 64 * j], sc = ((const f32x4*)(ab + 1024))[lane + 64 * j];
            const f32x4 sh2 = ((const f32x4*)ab2)[lane + 64 * j], sc2 = ((const f32x4*)(ab2 + 1024))[lane + 64 * j];
            const f32x4 h = (v[j] * rstd) * gg * (sc + 1.0f) + sh, h2 = (w[j] * rstd2) * gg * (sc2 + 1.0f) + sh2;
            u32x2 a; a.x = pk2(h.x, h.y); a.y = pk2(h.z, h.w); o8[64 * j] = a;
            u32x2 b; b.x = pk2(h2.x, h2.y); b.y = pk2(h2.z, h2.w); o82[64 * j] = b;
        }
    }
}

__device__ __forceinline__ void modnorm_rows_bf16(Frame& F, const bf16_t* X, const float* g, int ada_shift_off, bf16_t* O) {
    const int gw = F.bx * NWAVES + F.wave, NGW = F.G * NWAVES, lane = F.lane;
    const float* ada = WSP(float, WS_ADA);
    for (int m = gw; m < NTOK; m += 2 * NGW) {
        const int m2 = m + NGW;
        const u32x2* xr = (const u32x2*)(X + (size_t)m * DM) + lane; const u32x2* xr2 = (const u32x2*)(X + (size_t)m2 * DM) + lane;
        u32x2 a[4], b[4];
#pragma unroll
        for (int j = 0; j < 4; ++j) { a[j] = xr[64 * j]; b[j] = xr2[64 * j]; }
        f32x4 v[4], w[4]; float s = 0.f, s2 = 0.f;
#pragma unroll
        for (int j = 0; j < 4; ++j) {
            v[j] = (f32x4){__uint_as_float(a[j].x << 16), __uint_as_float(a[j].x & 0xffff0000u), __uint_as_float(a[j].y << 16), __uint_as_float(a[j].y & 0xffff0000u)};
            w[j] = (f32x4){__uint_as_float(b[j].x << 16), __uint_as_float(b[j].x & 0xffff0000u), __uint_as_float(b[j].y << 16), __uint_as_float(b[j].y & 0xffff0000u)};
            s += (v[j].x * v[j].x + v[j].y * v[j].y) + (v[j].z * v[j].z + v[j].w * v[j].w); s2 += (w[j].x * w[j].x + w[j].y * w[j].y) + (w[j].z * w[j].z + w[j].w * w[j].w);
        }
        const float rstd = rsqrtf(wave_sum(s) * (1.f / DM) + EPS), rstd2 = rsqrtf(wave_sum(s2) * (1.f / DM) + EPS);
        u32x2* o8 = (u32x2*)(O + (size_t)m * DM) + lane; u32x2* o82 = (u32x2*)(O + (size_t)m2 * DM) + lane;
        const float* ab = ada + (m >> 12) * 6144 + ada_shift_off; const float* ab2 = ada + (m2 >> 12) * 6144 + ada_shift_off;
#pragma unroll
        for (int j = 0; j < 4; ++j) {
            const f32x4 gg = ((const f32x4*)g)[lane + 64 * j];
            const f32x4 sh = ((const f32x4*)ab)[lane + 64 * j], sc = ((const f32x4*)(ab + 1024))[lane + 64 * j];
            const f32x4 sh2 = ((const f32x4*)ab2)[lane + 64 * j], sc2 = ((const f32x4*)(ab2 + 1024))[lane + 64 * j];
            const f32x4 h = (v[j] * rstd) * gg * (sc + 1.0f) + sh, h2 = (w[j] * rstd2) * gg * (sc2 + 1.0f) + sh2;
            u32x2 p; p.x = pk2(h.x, h.y); p.y = pk2(h.z, h.w); o8[64 * j] = p;
            u32x2 q; q.x = pk2(h2.x, h2.y); q.y = pk2(h2.z, h2.w); o82[64 * j] = q;
        }
    }
}

using g8::Unit; using g8::Acc;
__device__ __forceinline__ u32x4 pack8(const f32x4& a, const f32x4& b) { u32x4 w; w.x = pk2(a[0], a[1]); w.y = pk2(a[2], a[3]); w.z = pk2(b[0], b[1]); w.w = pk2(b[2], b[3]); return w; }

struct PolIn {
    static constexpr int K = 1024; static constexpr int EPI_STORES = 0;
    const char* A; const char* Bt; g8::StaticOrder so;
    bf16_t *U, *BG, *Q, *Kk, *V, *QI, *KI; float* WI; const float* rope; const float *gq, *gk, *gki;
    __device__ __forceinline__ const char* abase() const { return A; }
    __device__ __forceinline__ bool next(int i, Unit& u) const { return so.next(i, u); }
    __device__ __forceinline__ void arows(const Unit& u, int R0, unsigned (&ro)[2][2]) const {
#pragma unroll
        for (int h = 0; h < 2; ++h)
#pragma unroll
            for (int i = 0; i < 2; ++i) ro[h][i] = (unsigned)(256 * u.pm + 128 * h + 64 * i + R0) * 2048u;
    }
    __device__ __forceinline__ const char* bbase(const Unit& u) const { return Bt + (size_t)u.pn * 256 * 2048; }
    __device__ __forceinline__ void head_row(f32x4 a00, f32x4 a01, f32x4 a10, f32x4 a11, int row, int fq, const float* g, bool norm, float scale, bf16_t* dst) const {
        if (norm) {
            float ss = (a00[0] * a00[0] + a00[1] * a00[1]) + (a00[2] * a00[2] + a00[3] * a00[3]) + (a01[0] * a01[0] + a01[1] * a01[1]) + (a01[2] * a01[2] + a01[3] * a01[3])
                     + (a10[0] * a10[0] + a10[1] * a10[1]) + (a10[2] * a10[2] + a10[3] * a10[3]) + (a11[0] * a11[0] + a11[1] * a11[1]) + (a11[2] * a11[2] + a11[3] * a11[3]);
            ss += __shfl_xor(ss, 16); ss += __shfl_xor(ss, 32);
            const float rstd = rsqrtf(ss * (1.f / 64.f) + EPS);
            const f32x4* gp = (const f32x4*)(g + 16 * fq);
            a00 = a00 * rstd * gp[0]; a01 = a01 * rstd * gp[1]; a10 = a10 * rstd * gp[2]; a11 = a11 * rstd * gp[3];
        }
        if (fq == 0) {
            const f32x4* rp = (const f32x4*)(rope + (size_t)row * 16);
            const f32x4 c0 = rp[0], c1 = rp[1], s0 = rp[2], s1 = rp[3];
            const f32x4 x0 = a00, x1 = a01, y0 = a10, y1 = a11;
            a00 = x0 * c0 - y0 * s0; a10 = y0 * c0 + x0 * s0;
            a01 = x1 * c1 - y1 * s1; a11 = y1 * c1 + x1 * s1;
        }
        a00 = a00 * scale; a01 = a01 * scale; a10 = a10 * scale; a11 = a11 * scale;
        *(u32x4*)(dst + 16 * fq) = pack8(a00, a01);
        *(u32x4*)(dst + 16 * fq + 8) = pack8(a10, a11);
    }
    __device__ __forceinline__ void epi(const Acc& acc, const Unit& u, int wr, int wc, int fr, int fq) const {
        const int pn = u.pn;
#pragma unroll
        for (int ai = 0; ai < 2; ++ai)
#pragma unroll
            for (int m = 0; m < 4; ++m) {
                const int row = 256 * u.pm + 128 * ai + 64 * wr + 16 * m + fr;
                const f32x4 a00 = acc[ai][0][m][0], a01 = acc[ai][0][m][1], a10 = acc[ai][1][m][0], a11 = acc[ai][1][m][1];
                const int cc = 32 * wc + 8 * fq;
                if (pn < 4) {
                    *(u32x4*)(U + (size_t)row * 512 + 128 * pn + cc) = pack8(a00 * a10, a01 * a11);
                } else if (pn < 6) {
                    bf16_t* d = BG + (size_t)row * 512 + 256 * (pn - 4) + cc;
                    *(u32x4*)d = pack8(a00, a01); *(u32x4*)(d + 128) = pack8(a10, a11);
                } else if (pn < 8) {
                    head_row(a00, a01, a10, a11, row, fq, gq, true, QSCALE, Q + (size_t)row * 512 + (4 * (pn - 6) + wc) * 64);
                } else if (pn < 10) {
                    head_row(a00, a01, a10, a11, row, fq, gk, true, 1.0f, Kk + (size_t)row * 512 + (4 * (pn - 8) + wc) * 64);
                } else if (pn < 12) {
                    bf16_t* d = V + (size_t)row * 512 + 256 * (pn - 10) + cc;
                    *(u32x4*)d = pack8(a00, a01); *(u32x4*)(d + 128) = pack8(a10, a11);
                } else if (pn < 14) {
                    head_row(a00, a01, a10, a11, row, fq, gq, false, 1.0f, QI + (size_t)row * 512 + (4 * (pn - 12) + wc) * 64);
                } else {
                    if (wc == 0) head_row(a00, a01, a10, a11, row, fq, gki, true, 1.0f, KI + (size_t)row * 64);
                    else if (wc == 1 && fq == 0) { *(f32x4*)(WI + (size_t)row * 8) = a00; *(f32x4*)(WI + (size_t)row * 8 + 4) = a01; }
                }
            }
    }
};

struct PolOut {
    static constexpr int K = 1024; static constexpr int EPI_STORES = 0;
    const char* A; const char* Bt; g8::StaticOrder so; const float* x; const float* ada; float* out;
    __device__ __forceinline__ const char* abase() const { return A; }
    __device__ __forceinline__ bool next(int i, Unit& u) const { return so.next(i, u); }
    __device__ __forceinline__ void arows(const Unit& u, int R0, unsigned (&ro)[2][2]) const {
#pragma unroll
        for (int h = 0; h < 2; ++h)
#pragma unroll
            for (int i = 0; i < 2; ++i) ro[h][i] = (unsigned)(256 * u.pm + 128 * h + 64 * i + R0) * 2048u;
    }
    __device__ __forceinline__ const char* bbase(const Unit& u) const { return Bt + (size_t)u.pn * 256 * 2048; }
    __device__ __forceinline__ void epi(const Acc& acc, const Unit& u, int wr, int wc, int fr, int fq) const {
        const int b = u.pm >> 4;
        const float* gate = ada + b * 6144 + 2048;
        bf16_t* x1b = (bf16_t*)(out + (size_t)NTOK * DM / 2);
#pragma unroll
        for (int bj = 0; bj < 2; ++bj) {
            const int col = 256 * u.pn + 128 * bj + 32 * wc + 8 * fq;
            const f32x4 g0 = *(const f32x4*)(gate + col), g1 = *(const f32x4*)(gate + col + 4);
#pragma unroll
            for (int ai = 0; ai < 2; ++ai)
#pragma unroll
                for (int m = 0; m < 4; ++m) {
                    const size_t off = (size_t)(256 * u.pm + 128 * ai + 64 * wr + 16 * m + fr) * DM + col;
                    const f32x4 x0 = *(const f32x4*)(x + off), x1 = *(const f32x4*)(x + off + 4);
                    *(u32x4*)(x1b + off) = pack8(x0 + g0 * acc[ai][bj][m][0], x1 + g1 * acc[ai][bj][m][1]);
                }
        }
    }
};

__device__ __forceinline__ f32x4 swiglu4(const f32x4& a, const f32x4& b) {
    f32x4 r;
#pragma unroll
    for (int i = 0; i < 4; ++i) r[i] = a[i] * __builtin_amdgcn_rcpf(1.0f + __builtin_amdgcn_exp2f(-a[i] * LOG2E)) * b[i];
    return r;
}

struct PolS {
    static constexpr int K = 1024; static constexpr int EPI_STORES = 0;
    const char* A; const char* W13s; const char* Wr; int G, c; bf16_t* HIDS; float* LOGI;
    __device__ __forceinline__ const char* abase() const { return A; }
    __device__ __forceinline__ bool next(int i, Unit& u) const { const int L = i * G + c; if (L >= 384) return false; u.pm = L / 3; u.pn = L % 3; u.e = 0; u.j = 0; return true; }
    __device__ __forceinline__ void arows(const Unit& u, int R0, unsigned (&ro)[2][2]) const {
#pragma unroll
        for (int h = 0; h < 2; ++h)
#pragma unroll
            for (int i = 0; i < 2; ++i) ro[h][i] = (unsigned)(256 * u.pm + 128 * h + 64 * i + R0) * 2048u;
    }
    __device__ __forceinline__ const char* bbase(const Unit& u) const { return u.pn < 2 ? W13s + (size_t)u.pn * 256 * 2048 : Wr; }
    __device__ __forceinline__ void epi(const Acc& acc, const Unit& u, int wr, int wc, int fr, int fq) const {
#pragma unroll
        for (int ai = 0; ai < 2; ++ai)
#pragma unroll
            for (int m = 0; m < 4; ++m) {
                const int row = 256 * u.pm + 128 * ai + 64 * wr + 16 * m + fr;
                if (u.pn < 2) {
                    *(u32x4*)(HIDS + (size_t)row * 256 + 128 * u.pn + 32 * wc + 8 * fq) = pack8(swiglu4(acc[ai][0][m][0], acc[ai][1][m][0]), swiglu4(acc[ai][0][m][1], acc[ai][1][m][1]));
                } else if (wc < 2) {
                    float* d = LOGI + (size_t)row * 64 + 32 * wc + 8 * fq;
                    *(f32x4*)d = acc[ai][0][m][0]; *(f32x4*)(d + 4) = acc[ai][0][m][1];
                }
            }
    }
};

struct PolG1 {
    static constexpr int K = 1024; static constexpr int EPI_STORES = 0;
    const char* A; const char* W13; const int* PAIR; bf16_t* HID; int G, c; const volatile LAS int* tp; const volatile LAS int* cnt; const volatile LAS int* tpx;
    __device__ __forceinline__ const char* abase() const { return A; }
    __device__ __forceinline__ bool next(int i, Unit& u) const {
        const int L = i * 32 + (c >> 3); if (L >= 2 * __builtin_amdgcn_readfirstlane(tpx[8])) return false;
        const int tl = L >> 1; int k = 0;
        while (__builtin_amdgcn_readfirstlane(tpx[k + 1]) <= tl) ++k;
        const int e = (c & 7) + 8 * k, j = tl - __builtin_amdgcn_readfirstlane(tpx[k]);
        u.pm = __builtin_amdgcn_readfirstlane(tp[e]) + j; u.pn = L & 1; u.e = e; u.j = j; return true;
    }
    __device__ __forceinline__ void arows(const Unit& u, int R0, unsigned (&ro)[2][2]) const {
        const int ce = cnt[u.e];
#pragma unroll
        for (int h = 0; h < 2; ++h)
#pragma unroll
            for (int i = 0; i < 2; ++i) { const int pos = 256 * u.j + 128 * h + 64 * i + R0; const int p = (pos < ce) ? PAIR[u.e * PAIRCAP + pos] : 0; ro[h][i] = (unsigned)(p >> 3) * 2048u; }
    }
    __device__ __forceinline__ const char* bbase(const Unit& u) const { return W13 + ((size_t)u.e * 512 + 256 * u.pn) * 2048; }
    __device__ __forceinline__ void epi(const Acc& acc, const Unit& u, int wr, int wc, int fr, int fq) const {
        const int valid = cnt[u.e] - 256 * u.j;
#pragma unroll
        for (int ai = 0; ai < 2; ++ai)
#pragma unroll
            for (int m = 0; m < 4; ++m) {
                const int r = 128 * ai + 64 * wr + 16 * m + fr;
                if (r < valid)
                    *(u32x4*)(HID + (size_t)(256 * u.pm + r) * 256 + 128 * u.pn + 32 * wc + 8 * fq) = pack8(swiglu4(acc[ai][0][m][0], acc[ai][1][m][0]), swiglu4(acc[ai][0][m][1], acc[ai][1][m][1]));
            }
    }
};

struct PolG2 {
    static constexpr int K = 256; static constexpr int EPI_STORES = 8;
    const char* A; const char* W2; unsigned char* Y; int G, c; const volatile LAS int* tp; const volatile LAS int* tpx;
    __device__ __forceinline__ const char* abase() const { return A; }
    __device__ __forceinline__ bool next(int i, Unit& u) const {
        const int L = i * 32 + (c >> 3); if (L >= 4 * (16 + __builtin_amdgcn_readfirstlane(tpx[8]))) return false;
        const int tl = L >> 2; u.pn = L & 3; u.j = 0;
        if (tl < 16) { u.pm = 16 * (c & 7) + tl; u.e = 64; return true; }
        int k = 0;
        while (__builtin_amdgcn_readfirstlane(tpx[k + 1]) <= tl - 16) ++k;
        const int e = (c & 7) + 8 * k;
        u.pm = __builtin_amdgcn_readfirstlane(tp[e]) + (tl - 16 - __builtin_amdgcn_readfirstlane(tpx[k])); u.e = e; return true;
    }
    __device__ __forceinline__ void arows(const Unit& u, int R0, unsigned (&ro)[2][2]) const {
#pragma unroll
        for (int h = 0; h < 2; ++h)
#pragma unroll
            for (int i = 0; i < 2; ++i) ro[h][i] = (unsigned)(256 * u.pm + 128 * h + 64 * i + R0) * 512u;
    }
    __device__ __forceinline__ const char* bbase(const Unit& u) const { return W2 + ((size_t)u.e * 1024 + 256 * u.pn) * 512; }
    __device__ __forceinline__ void epi(const Acc& acc, const Unit& u, int wr, int wc, int fr, int fq) const {
#pragma unroll
        for (int ai = 0; ai < 2; ++ai)
#pragma unroll
            for (int m = 0; m < 4; ++m) {
                const f32x4 a = acc[ai][0][m][0] * 16.0f, b = acc[ai][0][m][1] * 16.0f, c2 = acc[ai][1][m][0] * 16.0f, d = acc[ai][1][m][1] * 16.0f;
                u32x4 w;
                w.x = (unsigned)__builtin_amdgcn_cvt_pk_fp8_f32(a[2], a[3], __builtin_amdgcn_cvt_pk_fp8_f32(a[0], a[1], 0, false), true);
                w.y = (unsigned)__builtin_amdgcn_cvt_pk_fp8_f32(b[2], b[3], __builtin_amdgcn_cvt_pk_fp8_f32(b[0], b[1], 0, false), true);
                w.z = (unsigned)__builtin_amdgcn_cvt_pk_fp8_f32(c2[2], c2[3], __builtin_amdgcn_cvt_pk_fp8_f32(c2[0], c2[1], 0, false), true);
                w.w = (unsigned)__builtin_amdgcn_cvt_pk_fp8_f32(d[2], d[3], __builtin_amdgcn_cvt_pk_fp8_f32(d[0], d[1], 0, false), true);
                *(u32x4*)(Y + (size_t)(256 * u.pm + 128 * ai + 64 * wr + 16 * m + fr) * 1024 + 256 * u.pn + 64 * wc + 16 * fq) = w;
            }
    }
};

__device__ __forceinline__ void acc_fp8x16(f32x4 (&s)[4], const u32x4& w, float g) {
#pragma unroll
    for (int i = 0; i < 4; ++i) {
        const f32x2 lo = __builtin_amdgcn_cvt_pk_f32_fp8((int)w[i], false), hi = __builtin_amdgcn_cvt_pk_f32_fp8((int)w[i], true);
        s[i][0] += g * lo[0]; s[i][1] += g * lo[1]; s[i][2] += g * hi[0]; s[i][3] += g * hi[1];
    }
}
__device__ __forceinline__ void combine_token(const unsigned char* Y, const float* ada, const volatile LAS int* tp, float* out, int t, int lane, int meta, const u32x4& xa, const u32x4& xb) {
    const int row_own = 256 * tp[(meta >> 15) & 63] + (meta & (PAIRCAP - 1));
    u32x4 w[9]; float g[8];
    w[8] = *(const u32x4*)(Y + (size_t)t * 1024 + lane * 16);
#pragma unroll
    for (int k = 0; k < 8; ++k) {
        const int row = __builtin_amdgcn_readlane(row_own, k); g[k] = __int_as_float(__builtin_amdgcn_readlane(meta, 8 + k)) * (1.0f / 16.0f);
        w[k] = *(const u32x4*)(Y + (size_t)row * 1024 + lane * 16);
    }
    float* op = out + (size_t)t * DM + lane * 16;
    const float* gp = ada + (t >> 12) * 6144 + 5120 + lane * 16;
    f32x4 x[4], gg[4], s[4];
    x[0] = (f32x4){__uint_as_float(xa.x << 16), __uint_as_float(xa.x & 0xffff0000u), __uint_as_float(xa.y << 16), __uint_as_float(xa.y & 0xffff0000u)};
    x[1] = (f32x4){__uint_as_float(xa.z << 16), __uint_as_float(xa.z & 0xffff0000u), __uint_as_float(xa.w << 16), __uint_as_float(xa.w & 0xffff0000u)};
    x[2] = (f32x4){__uint_as_float(xb.x << 16), __uint_as_float(xb.x & 0xffff0000u), __uint_as_float(xb.y << 16), __uint_as_float(xb.y & 0xffff0000u)};
    x[3] = (f32x4){__uint_as_float(xb.z << 16), __uint_as_float(xb.z & 0xffff0000u), __uint_as_float(xb.w << 16), __uint_as_float(xb.w & 0xffff0000u)};
#pragma unroll
    for (int i = 0; i < 4; ++i) { gg[i] = *(const f32x4*)(gp + 4 * i); s[i] = (f32x4){0.f, 0.f, 0.f, 0.f}; }
    acc_fp8x16(s, w[8], 1.0f / 16.0f);
#pragma unroll
    for (int k = 0; k < 8; ++k) acc_fp8x16(s, w[k], g[k]);
#pragma unroll
    for (int i = 0; i < 4; ++i) *(f32x4*)(op + 4 * i) = x[i] + gg[i] * s[i];
}
template <class Bar>
__device__ __forceinline__ void combine_phase(Frame& F, float* out, Bar&& grid_bar) {
    const unsigned char* Y = WSP(unsigned char, WS_Y); const float* ada = WSP(float, WS_ADA); const int* INV = WSP(int, WS_INV); const int* GATEI = WSP(int, WS_GATE);
    const volatile LAS int* tp = (const volatile LAS int*)(F.MISC + MW_TP);
    const bf16_t* x1b = (const bf16_t*)(out + (size_t)NTOK * DM / 2);
    int gw = F.bx * NWAVES + F.wave, NGW = F.G * NWAVES, lane = F.lane;
    auto fetch_meta = [&](int t) -> int { int v = 0; if (lane < 16) v = (lane < 8) ? INV[t * 8 + lane] : GATEI[t * 8 + lane - 8]; return v; };
    constexpr int NH = NTOK / 2;
    {
        int t = gw, meta = fetch_meta(t);
        for (; t < NH; t += NGW) {
            const u32x4 xa = *(const u32x4*)(x1b + (size_t)t * DM + lane * 16), xb = *(const u32x4*)(x1b + (size_t)t * DM + lane * 16 + 8);
            const int mnext = (t + NGW < NH) ? fetch_meta(t + NGW) : 0;
            combine_token(Y, ada, tp, out, t, lane, meta, xa, xb);
            meta = mnext;
        }
    }
    grid_bar();
    gw = F.bx * NWAVES + F.wave; lane = F.lane;
    u32x4 xa[8], xb[8];
#pragma unroll
    for (int i = 0; i < 8; ++i) { const int t = NH + gw + i * NGW; xa[i] = *(const u32x4*)(x1b + (size_t)t * DM + lane * 16); xb[i] = *(const u32x4*)(x1b + (size_t)t * DM + lane * 16 + 8); }
    asm volatile("" :: "v"(xa[0]), "v"(xa[1]), "v"(xa[2]), "v"(xa[3]), "v"(xa[4]), "v"(xa[5]), "v"(xa[6]), "v"(xa[7]), "v"(xb[0]), "v"(xb[1]), "v"(xb[2]), "v"(xb[3]), "v"(xb[4]), "v"(xb[5]), "v"(xb[6]), "v"(xb[7]));
    grid_bar();
    gw = F.bx * NWAVES + F.wave; lane = F.lane;
    {
        int meta = fetch_meta(NH + gw);
#pragma unroll
        for (int i = 0; i < 8; ++i) {
            const int t = NH + gw + i * NGW;
            const int mnext = (i < 7) ? fetch_meta(t + NGW) : 0;
            combine_token(Y, ada, tp, out, t, lane, meta, xa[i], xb[i]);
            meta = mnext;
        }
    }
}

struct ConvIn { u32x4 u0, u1, u2, bg; };
__device__ __forceinline__ ConvIn conv_load(const bf16_t* U, const bf16_t* BG, int it) {
    const int tok = it >> 6, c0 = (it & 63) * 8, t = tok & (SEQ - 1);
    ConvIn r; const u32x4 z = {0u, 0u, 0u, 0u};
    r.u2 = *(const u32x4*)(U + (size_t)tok * 512 + c0);
    r.u1 = (t >= 1) ? *(const u32x4*)(U + (size_t)(tok - 1) * 512 + c0) : z;
    r.u0 = (t >= 2) ? *(const u32x4*)(U + (size_t)(tok - 2) * 512 + c0) : z;
    r.bg = *(const u32x4*)(BG + (size_t)tok * 512 + c0);
    return r;
}
__device__ __forceinline__ void conv_store(const ConvIn& in, const float* conv_w, bf16_t* MIX, int it) {
    const int tok = it >> 6, c0 = (it & 63) * 8;
    float r[8];
#pragma unroll
    for (int j = 0; j < 8; ++j) {
        const int w = j >> 1;
        const float f0 = __uint_as_float((j & 1) ? (in.u0[w] & 0xffff0000u) : (in.u0[w] << 16));
        const float f1 = __uint_as_float((j & 1) ? (in.u1[w] & 0xffff0000u) : (in.u1[w] << 16));
        const float f2 = __uint_as_float((j & 1) ? (in.u2[w] & 0xffff0000u) : (in.u2[w] << 16));
        const float fb = __uint_as_float((j & 1) ? (in.bg[w] & 0xffff0000u) : (in.bg[w] << 16));
        r[j] = fb * (conv_w[c0 + j] * f0 + conv_w[512 + c0 + j] * f1 + conv_w[1024 + c0 + j] * f2);
    }
    u32x4 o; o.x = pk2(r[0], r[1]); o.y = pk2(r[2], r[3]); o.z = pk2(r[4], r[5]); o.w = pk2(r[6], r[7]);
    *(u32x4*)(MIX + (size_t)tok * 1024 + c0) = o;
}
__device__ __forceinline__ void conv_phase(Frame& F, ArgsP ap) {
    const float* conv_w = ap->conv_w;
    const bf16_t* U = WSP(bf16_t, WS_U); const bf16_t* BG = WSP(bf16_t, WS_BG); bf16_t* MIX = WSP(bf16_t, WS_MIX);
    const int stride = F.G * NTHR;
    for (int it = F.bx * NTHR + F.tid; it < NTOK * 64; it += 4 * stride) {
        const ConvIn a = conv_load(U, BG, it), b = conv_load(U, BG, it + stride), c = conv_load(U, BG, it + 2 * stride), d = conv_load(U, BG, it + 3 * stride);
        conv_store(a, conv_w, MIX, it); conv_store(b, conv_w, MIX, it + stride); conv_store(c, conv_w, MIX, it + 2 * stride); conv_store(d, conv_w, MIX, it + 3 * stride);
    }
}

__device__ __forceinline__ void indexer_unit(Frame& F, int b, int qblk) {
    const int lane = F.lane, wid = F.wave, q0 = qblk * 16, nsteps = qblk + 1;
    const bf16_t* QI = WSP(bf16_t, WS_QI); const bf16_t* KI = WSP(bf16_t, WS_KI); const float* WI = WSP(float, WS_WI);
    unsigned long long* MASK = WSP(unsigned long long, WS_MASK);
    LAS unsigned short* sc16 = (LAS unsigned short*)F.lds;
    const int g = lane >> 4, c = lane & 15;
    LAS unsigned* hist = (LAS unsigned*)(F.lds + HIST_OFF);
    { LAS u32x4* hz = (LAS u32x4*)hist; hz[F.tid] = (u32x4){0u, 0u, 0u, 0u}; hz[F.tid + NTHR] = (u32x4){0u, 0u, 0u, 0u}; }
    __syncthreads();
    {
        bf16x8 afr[8][2];
        const bf16_t* qb = QI + (size_t)(b * SEQ + q0 + c) * 512 + 8 * g;
#pragma unroll
        for (int h = 0; h < 8; ++h)
#pragma unroll
            for (int ks = 0; ks < 2; ++ks) afr[h][ks] = *(const bf16x8*)(qb + h * 64 + ks * 32);
        f32x4 wv[4][2];
#pragma unroll
        for (int j = 0; j < 4; ++j) { const float* wp = WI + (size_t)(b * SEQ + q0 + 4 * g + j) * 8; wv[j][0] = *(const f32x4*)wp; wv[j][1] = *(const f32x4*)(wp + 4); }
        const bf16_t* kb = KI + (size_t)(b * SEQ + c) * 64 + 8 * g;
        bf16x8 kA0, kA1, kB0, kB1;
        float big_ = __builtin_inff(); asm volatile("" : "+v"(big_));
#define IX_LOAD(X0, X1, st) do { const int st_ = ((st) < nsteps) ? (st) : 0; X0 = *(const bf16x8*)(kb + (size_t)st_ * 1024); X1 = *(const bf16x8*)(kb + (size_t)st_ * 1024 + 32); } while (0)
#define IX_STEP(X0, X1, st) do { { \
            float sc[4] = {0.f, 0.f, 0.f, 0.f}; \
            _Pragma("unroll") for (int h = 0; h < 8; ++h) { \
                f32x4 d = {0.f, 0.f, 0.f, 0.f}; \
                d = __builtin_amdgcn_mfma_f32_16x16x32_bf16(afr[h][0], X0, d, 0, 0, 0); \
                d = __builtin_amdgcn_mfma_f32_16x16x32_bf16(afr[h][1], X1, d, 0, 0, 0); \
                _Pragma("unroll") for (int j = 0; j < 4; ++j) sc[j] = fmaf(__builtin_amdgcn_fmed3f(d[j], 0.f, big_), wv[j][h >> 2][h & 3], sc[j]); } \
            _Pragma("unroll") for (int j = 0; j < 4; ++j) { \
                const float v = __builtin_amdgcn_fmed3f(sc[j] * 256.0f + 32768.5f, 1.0f, 65535.0f); \
                const unsigned k16_ = (unsigned)(int)v; \
                sc16[((st) < nsteps) ? ((4 * g + j) * 4096 + (st) * 16 + c) : (65536 + 4096 + lane)] = (unsigned short)k16_; \
                if ((st) * 16 + c <= q0 + 4 * g + j) __hip_atomic_fetch_add(hist + (4 * g + j) * 256 + (k16_ >> 8), 1u << ((k16_ >> 3) & 16), __ATOMIC_RELAXED, __HIP_MEMORY_SCOPE_WORKGROUP); } } } while (0)
        IX_LOAD(kA0, kA1, wid); IX_LOAD(kB0, kB1, wid + 8);
        for (int s = wid; s < nsteps; s += 16) {
            IX_STEP(kA0, kA1, s);     IX_LOAD(kA0, kA1, s + 16);
            IX_STEP(kB0, kB1, s + 8); IX_LOAD(kB0, kB1, s + 24);
        }
#undef IX_LOAD
#undef IX_STEP
    }
    __syncthreads();
    for (int qq = 2 * wid; qq < 2 * wid + 2; ++qq) {
        const int q = q0 + qq, n = q + 1, ngrp = (q >> 9) + 1;
        unsigned pk[32];
#pragma unroll
        for (int j = 0; j < 32; ++j) {
            pk[j] = 0u;
            if ((j >> 2) < ngrp) {
                const int ka = 128 * j + lane, kb2 = ka + 64;
                const unsigned va = sc16[qq * 4096 + ka], vb = sc16[qq * 4096 + kb2];
                pk[j] = ((ka <= q) ? va : 0u) | (((kb2 <= q) ? vb : 0u) << 16);
            }
        }
        unsigned lo = 1u, hi = 65536u; int c_lo = n, c_hi = 0;
        unsigned one2 = 0x00010001u; asm volatile("" : "+v"(one2));
        if (n > 256) {
            const u32x4 hw = *(const LAS u32x4*)(hist + qq * 256 + 4 * lane);
            int hb[8] = {(int)(hw.x & 0xffffu), (int)(hw.x >> 16), (int)(hw.y & 0xffffu), (int)(hw.y >> 16), (int)(hw.z & 0xffffu), (int)(hw.z >> 16), (int)(hw.w & 0xffffu), (int)(hw.w >> 16)};
            int tot = ((hb[0] + hb[1]) + (hb[2] + hb[3])) + ((hb[4] + hb[5]) + (hb[6] + hb[7]));
            int suf = tot;
#pragma unroll
            for (int d = 1; d < 64; d <<= 1) { const int o = __shfl_down(suf, d); suf += (lane + d < 64) ? o : 0; }
            int above = suf - tot;
            const bool mine_ = (suf >= 256) && (above < 256);
            int Bsel = 0, cl = 0, ch = 0;
#pragma unroll
            for (int i = 7; i >= 0; --i) { const int cge = above + hb[i]; if (above < 256 && cge >= 256) { Bsel = 8 * lane + i; cl = cge; ch = above; } above = cge; }
            const unsigned long long mb = __ballot(mine_);
            const int src = (int)__builtin_ctzll(mb);
            const int B = __builtin_amdgcn_readlane(Bsel, src); c_lo = __builtin_amdgcn_readlane(cl, src); c_hi = __builtin_amdgcn_readlane(ch, src);
            lo = (unsigned)B << 7; hi = lo + 128u; if (lo == 0u) lo = 1u;
        }
        if (n > 256 && c_lo != 256) {
            while (hi - lo > 1u) {
                const unsigned mid = (lo + hi) >> 1;
                const unsigned tm1 = (mid - 1u) * 0x00010001u;
                unsigned acc2 = 0u;
#pragma unroll
                for (int gq = 0; gq < 8; ++gq)
                    if (gq < ngrp) {
                        unsigned d0, d1, d2, d3;
                        asm("v_pk_sub_u16 %1, %5, %9 clamp\n\tv_pk_sub_u16 %2, %6, %9 clamp\n\tv_pk_sub_u16 %3, %7, %9 clamp\n\tv_pk_sub_u16 %4, %8, %9 clamp\n\t"
                            "v_pk_min_u16 %1, %1, %10\n\tv_pk_min_u16 %2, %2, %10\n\tv_pk_min_u16 %3, %3, %10\n\tv_pk_min_u16 %4, %4, %10\n\t"
                            "v_pk_add_u16 %1, %1, %2\n\tv_pk_add_u16 %3, %3, %4\n\tv_pk_add_u16 %0, %0, %1\n\tv_pk_add_u16 %0, %0, %3"
                            : "+v"(acc2), "=&v"(d0), "=&v"(d1), "=&v"(d2), "=&v"(d3)
                            : "v"(pk[4 * gq]), "v"(pk[4 * gq + 1]), "v"(pk[4 * gq + 2]), "v"(pk[4 * gq + 3]), "s"(tm1), "v"(one2));
                    }
                const int cc = wave_sum_i((int)((acc2 & 0xffffu) + (acc2 >> 16)));
                if (cc >= 256) { lo = mid; c_lo = cc; if (cc == 256) break; } else { hi = mid; c_hi = cc; }
            }
        }
        unsigned long long mine = 0ull;
        if (n <= 256 || c_lo == 256) {
#pragma unroll
            for (int j = 0; j < 32; ++j)
                if ((j >> 2) < ngrp) {
                    const unsigned long long ma = __ballot((pk[j] & 0xffffu) >= lo), mb = __ballot((pk[j] >> 16) >= lo);
                    mine = (lane == 2 * j) ? ma : mine; mine = (lane == 2 * j + 1) ? mb : mine;
                }
        } else {
            int need = 256 - c_hi;
            const unsigned long long lt = (1ull << lane) - 1ull;
#pragma unroll
            for (int j = 0; j < 32; ++j)
                if ((j >> 2) < ngrp) {
#pragma unroll
                    for (int hh = 0; hh < 2; ++hh) {
                        const unsigned kk = hh ? (pk[j] >> 16) : (pk[j] & 0xffffu);
                        const unsigned long long eq = __ballot(kk == lo);
                        const int rank = __popcll(eq & lt);
                        const bool sel = (kk > lo) || (kk == lo && rank < need);
                        need -= __popcll(eq); need = need < 0 ? 0 : need;
                        const unsigned long long mk = __ballot(sel); mine = (lane == 2 * j + hh) ? mk : mine;
                    }
                }
        }
        MASK[(size_t)(b * SEQ + q) * 64 + lane] = mine;
    }
    __syncthreads();
}
__device__ __forceinline__ void indexer_phase(Frame& F) {
    const int b = F.bx & 7, j = F.bx >> 3;
    if (F.G != 256) {
        for (int u = F.bx; u < NB * 256; u += F.G) indexer_unit(F, u >> 8, u & 255);
        return;
    }
    for (int k = 0; k < 4; ++k) { indexer_unit(F, b, 64 * k + j); indexer_unit(F, b, 64 * k + 63 - j); }
}

__device__ __forceinline__ int crow(int r, int hi) { return (r & 3) + 8 * (r >> 2) + 4 * hi; }
__device__ __forceinline__ s16x4 vtr(const LAS char* p) { typedef short v4i16_t __attribute__((ext_vector_type(4))); return __builtin_bit_cast(s16x4, __builtin_amdgcn_ds_read_tr16_b64_v4i16((LAS v4i16_t*)p)); }
__device__ __forceinline__ void glds16(const void* gsrc, unsigned lds_dst) { unsigned keep;
    asm volatile("s_mov_b32 %0, m0\n\ts_mov_b32 m0, %2\n\ts_nop 0\n\tglobal_load_lds_dwordx4 %1, off\n\ts_mov_b32 m0, %0" : "=&s"(keep) : "v"(gsrc), "s"(lds_dst) : "memory"); }
__device__ __forceinline__ void glds4(const void* gsrc, unsigned lds_dst) { unsigned keep;
    asm volatile("s_mov_b32 %0, m0\n\ts_mov_b32 m0, %2\n\ts_nop 0\n\tglobal_load_lds_dword %1, off\n\ts_mov_b32 m0, %0" : "=&s"(keep) : "v"(gsrc), "s"(lds_dst) : "memory"); }
__device__ __forceinline__ void attn_unit(Frame& F, int b, int h, int qb, float mfix) {
    const int lane = F.lane, wid = F.wave, r32 = lane & 31, hi = lane >> 5;
    const bf16_t* Q = WSP(bf16_t, WS_Q); const bf16_t* Kp = WSP(bf16_t, WS_K); const bf16_t* Vp = WSP(bf16_t, WS_V); bf16_t* MIX = WSP(bf16_t, WS_MIX);
    const unsigned long long* MASK = WSP(unsigned long long, WS_MASK);
    LAS unsigned char* lds = F.lds;
    const unsigned lds0 = (unsigned)(unsigned long)lds;
    const size_t rowbase = (size_t)b * SEQ; const int q0 = qb * 256, qw0 = q0 + wid * 32;
    const int NTL = (q0 + 256) / 64;
    const int myq = qw0 + r32;
    const bf16_t* Kh = Kp + rowbase * 512 + h * 64; const bf16_t* Vh = Vp + rowbase * 512 + h * 64;
    const bf16_t* ksrc = Kh + (size_t)lane * 512 + wid * 8;
    const bf16_t* vsrc = Vh + (size_t)(16 * (wid & 3) + (lane >> 2)) * 512 + (wid >> 2) * 32 + (lane & 3) * 8;
    const unsigned* msrc = (const unsigned*)(MASK + (rowbase + qw0 + (lane >> 1)) * 64) + (lane & 1);
    const unsigned kdst = lds0 + (unsigned)wid * 1024u, vdst = lds0 + 32768u + (unsigned)wid * 1024u, mdst = lds0 + 65536u + (unsigned)wid * 256u;
#define AT_DMA(t) do { const unsigned sl_ = (unsigned)((t) & 3); \
        glds16(ksrc + (size_t)(t) * 64 * 512, (unsigned)__builtin_amdgcn_readfirstlane(kdst + sl_ * 8192u)); \
        glds16(vsrc + (size_t)(t) * 64 * 512, (unsigned)__builtin_amdgcn_readfirstlane(vdst + sl_ * 8192u)); \
        glds4(msrc + (size_t)(t) * 2, (unsigned)__builtin_amdgcn_readfirstlane(mdst + sl_ * 2048u)); } while (0)
    bf16x8 qr[4];
    { const bf16_t* Qw = Q + (rowbase + myq) * 512 + h * 64;
#pragma unroll
      for (int d0 = 0; d0 < 4; ++d0) qr[d0] = *(const bf16x8*)(Qw + d0 * 16 + hi * 8); }
    asm volatile("" :: "v"(qr[0]), "v"(qr[1]), "v"(qr[2]), "v"(qr[3]));
    f32x16 o0 = {}, o1 = {}, osum = {};
    const bf16x8 ones8 = {0x3F80, 0x3F80, 0x3F80, 0x3F80, 0x3F80, 0x3F80, 0x3F80, 0x3F80};
    (void)mfix;
    const int lastq_tile = (qw0 + 31) >> 6;
    AT_DMA(0); AT_DMA(1); AT_DMA(2);
    for (int t = 0; t < NTL; ++t) {
        if (t + 2 < NTL) asm volatile("s_waitcnt vmcnt(6) lgkmcnt(0)\n\ts_barrier" ::: "memory");
        else if (t + 1 < NTL) asm volatile("s_waitcnt vmcnt(3) lgkmcnt(0)\n\ts_barrier" ::: "memory");
        else asm volatile("s_waitcnt vmcnt(0) lgkmcnt(0)\n\ts_barrier" ::: "memory");
        if (t + 3 < NTL) AT_DMA(t + 3);
        if (t <= lastq_tile) {
            const int sl = t & 3;
            const LAS char* kb = (const LAS char*)(lds + sl * 8192) + hi * 1024 + r32 * 16;
            const LAS char* vb = (const LAS char*)(lds + 32768 + sl * 8192) + ((lane >> 4) & 1) * 32 + (lane & 3) * 8 + (4 * hi + ((lane & 15) >> 2)) * 64;
            bf16x8 kf[8];
#pragma unroll
            for (int d0 = 0; d0 < 4; ++d0) { kf[2 * d0] = *(const LAS bf16x8*)(kb + d0 * 2048); kf[2 * d0 + 1] = *(const LAS bf16x8*)(kb + d0 * 2048 + 512); }
            const unsigned long long mcur = *(const LAS unsigned long long*)(lds + 65536 + sl * 2048 + wid * 256 + r32 * 8);
            s16x4 vl0[4], vh0[4], vl1[4], vh1[4];
#pragma unroll
            for (int ks = 0; ks < 4; ++ks) { vl0[ks] = vtr(vb + ks * 1024); vh0[ks] = vtr(vb + ks * 1024 + 512); vl1[ks] = vtr(vb + 4096 + ks * 1024); vh1[ks] = vtr(vb + 4096 + ks * 1024 + 512); }
            __builtin_amdgcn_sched_barrier(0);
            f32x16 p0 = {}, p1 = {};
#pragma unroll
            for (int d0 = 0; d0 < 4; ++d0) {
                p0 = __builtin_amdgcn_mfma_f32_32x32x16_bf16(kf[2 * d0], qr[d0], p0, 0, 0, 0);
                p1 = __builtin_amdgcn_mfma_f32_32x32x16_bf16(kf[2 * d0 + 1], qr[d0], p1, 0, 0, 0);
            }
            const unsigned m0 = (unsigned)(mcur) >> (4 * hi), m1 = (unsigned)(mcur >> 32) >> (4 * hi);
#pragma unroll
            for (int r = 0; r < 16; ++r) {
                const int bit = (r & 3) + 8 * (r >> 2);
                const float e0 = __builtin_amdgcn_exp2f(p0[r]), e1 = __builtin_amdgcn_exp2f(p1[r]);
                p0[r] = __int_as_float(__float_as_int(e0) & ((int)(m0 << (31 - bit)) >> 31)); p1[r] = __int_as_float(__float_as_int(e1) & ((int)(m1 << (31 - bit)) >> 31));
            }
            u32x4 pw[4];
#pragma unroll
            for (int ks = 0; ks < 4; ++ks) {
                const int bs = 8 * (ks & 1);
                if (ks < 2) pw[ks] = (u32x4){pk2(p0[bs], p0[bs + 1]), pk2(p0[bs + 2], p0[bs + 3]), pk2(p0[bs + 4], p0[bs + 5]), pk2(p0[bs + 6], p0[bs + 7])};
                else        pw[ks] = (u32x4){pk2(p1[bs], p1[bs + 1]), pk2(p1[bs + 2], p1[bs + 3]), pk2(p1[bs + 4], p1[bs + 5]), pk2(p1[bs + 6], p1[bs + 7])};
            }
#pragma unroll
            for (int ks = 0; ks < 4; ++ks) {
                const bf16x8 v0 = (bf16x8){vl0[ks][0], vl0[ks][1], vl0[ks][2], vl0[ks][3], vh0[ks][0], vh0[ks][1], vh0[ks][2], vh0[ks][3]};
                const bf16x8 v1 = (bf16x8){vl1[ks][0], vl1[ks][1], vl1[ks][2], vl1[ks][3], vh1[ks][0], vh1[ks][1], vh1[ks][2], vh1[ks][3]};
                const bf16x8 pa = __builtin_bit_cast(bf16x8, pw[ks]);
                o0 = __builtin_amdgcn_mfma_f32_32x32x16_bf16(pa, v0, o0, 0, 0, 0);
                o1 = __builtin_amdgcn_mfma_f32_32x32x16_bf16(pa, v1, o1, 0, 0, 0);
                osum = __builtin_amdgcn_mfma_f32_32x32x16_bf16(pa, ones8, osum, 0, 0, 0);
            }
        }
    }
    bf16_t* Ow = MIX + (rowbase + qw0) * 1024 + 512 + h * 64;
#pragma unroll
    for (int r = 0; r < 16; ++r) {
        const int qrow = crow(r, hi);
        const float li = 1.0f / osum[r];
        Ow[(size_t)qrow * 1024 + r32] = (bf16_t)(pk2(o0[r] * li, 0.f) & 0xffffu);
        Ow[(size_t)qrow * 1024 + 32 + r32] = (bf16_t)(pk2(o1[r] * li, 0.f) & 0xffffu);
    }
    asm volatile("s_waitcnt lgkmcnt(0)\n\ts_barrier" ::: "memory");
#undef AT_DMA
}
__device__ __forceinline__ void attn_phase(Frame& F, ArgsP ap) {
    float mg = fabsf(ap->q_g[F.lane]), mk = fabsf(ap->k_g[F.lane]);
    mg = wave_max(mg); mk = wave_max(mk);
    const float mfix = 8.0f * mg * mk * LOG2E + 0.125f;
    if (F.G == 256) {
        const int vcu = (F.bx % 8) * 32 + F.bx / 8, bh = vcu >> 2, s = vcu & 3;
        const int qbs[4] = {s, 7 - s, 8 + s, 15 - s};
#pragma unroll
        for (int i = 0; i < 4; ++i) attn_unit(F, bh >> 3, bh & 7, qbs[i], mfix);
    } else {
        for (int u = F.bx; u < 1024; u += F.G) attn_unit(F, u >> 7, (u >> 4) & 7, u & 15, mfix);
    }
}

__device__ __forceinline__ void route_phase(Frame& F, ArgsP ap) {
    const float* router_bias = ap->router_bias;
    volatile LAS unsigned* lcnt = F.MISC + MW_LCNT; volatile LAS unsigned* lbase = F.MISC + MW_BASE;
    const float* LOGI = WSP(float, WS_LOG); int* PAIR = WSP(int, WS_PAIR); float* GATE = WSP(float, WS_GATE); int* INV = WSP(int, WS_INV);
    unsigned* gcnt = (unsigned*)(F.ws + WS_CTL) + CW_CNT;
    for (int blk = F.bx; blk < NTOK / 128; blk += F.G) {
        if (F.tid < 64) lcnt[F.tid] = 0u;
        __syncthreads();
        int ei[8]; float gi[8]; unsigned lp[8];
        const int t = blk * 128 + F.tid;
        if (F.tid < 128) {
            float sc[64], sel[64];
#pragma unroll
            for (int j = 0; j < 16; ++j) { const f32x4 v = ((const f32x4*)(LOGI + (size_t)t * 64))[j];
#pragma unroll
                for (int e = 0; e < 4; ++e) { const float s = 1.0f / (1.0f + __expf(-v[e])); sc[4 * j + e] = s; sel[4 * j + e] = s + router_bias[4 * j + e]; } }
            float gs = 0.f;
#pragma unroll
            for (int k = 0; k < 8; ++k) {
                float best = -INFINITY, bs = 0.f; int bi = 0;
#pragma unroll
                for (int e = 0; e < 64; ++e) { const bool gt = sel[e] > best; best = gt ? sel[e] : best; bs = gt ? sc[e] : bs; bi = gt ? e : bi; }
#pragma unroll
                for (int e = 0; e < 64; ++e) sel[e] = (e == bi) ? -INFINITY : sel[e];
                ei[k] = bi; gi[k] = bs; gs += bs;
            }
            const float gn = 2.5f / gs;
#pragma unroll
            for (int k = 0; k < 8; ++k) { gi[k] *= gn; lp[k] = __hip_atomic_fetch_add((LAS unsigned*)&lcnt[ei[k]], 1u, __ATOMIC_RELAXED, __HIP_MEMORY_SCOPE_WORKGROUP); }
        }
        __syncthreads();
        if (F.tid < 64) lbase[F.tid] = __hip_atomic_fetch_add(gcnt + F.tid, lcnt[F.tid], __ATOMIC_RELAXED, __HIP_MEMORY_SCOPE_AGENT);
        __syncthreads();
        if (F.tid < 128) {
#pragma unroll
            for (int k = 0; k < 8; ++k) { const int idx = ei[k] * PAIRCAP + (int)(lbase[ei[k]] + lp[k]); PAIR[idx] = t * 8 + k; INV[t * 8 + k] = idx; GATE[t * 8 + k] = gi[k]; }
        }
        __syncthreads();
    }
}
__device__ __forceinline__ void load_expert_tables(Frame& F) {
    volatile LAS int* tp = (volatile LAS int*)(F.MISC + MW_TP); volatile LAS int* cnt = (volatile LAS int*)(F.MISC + MW_CNT);
    unsigned* gcnt = (unsigned*)(F.ws + WS_CTL) + CW_CNT;
    if (F.tid < 64) cnt[F.tid] = (int)__hip_atomic_load(gcnt + F.tid, __ATOMIC_RELAXED, __HIP_MEMORY_SCOPE_AGENT);
    __syncthreads();
    if (F.tid == 0) { int s = SH_TILES; for (int e = 0; e < 64; ++e) { tp[e] = s; s += (cnt[e] + 255) >> 8; } tp[64] = s;
        volatile LAS int* tpx = (volatile LAS int*)(F.MISC + MW_TPX); const int x = F.bx & 7; int sx = 0;
        for (int k = 0; k < 8; ++k) { tpx[k] = sx; sx += (cnt[x + 8 * k] + 255) >> 8; } tpx[8] = sx; }
    __syncthreads();
}

__global__ void __launch_bounds__(NTHR, 2) hymba_fwd(Args args) {
    extern __shared__ __attribute__((aligned(16))) unsigned char lds_raw[];
    Frame F;
    F.lds = (LAS unsigned char*)lds_raw; F.MISC = (volatile LAS unsigned*)(F.lds + MISC_OFF);
    F.G = gridDim.x;
    ArgsP ap = refresh(F);
    for (int u = F.tid; u < MISC_BYTES / 4; u += NTHR) F.MISC[u] = 0u;
    __syncthreads();
    XcdBarrier bar = xcd_barrier_post((unsigned*)(F.ws + WS_CTL) + CW_BAR, F.MISC + 8);
#define GRID_BAR() do { xcd_barrier(bar); ap = refresh(F); } while (0)
#ifndef PH_MASK
#define PH_MASK 0xFFFF
#endif
#define PH(k) ((PH_MASK >> (k)) & 1)
#ifndef REP_K
#define REP_K -1
#endif
#define RUN(k, ...) do { __VA_ARGS__; if ((k) == REP_K) { ap = refresh(F); __VA_ARGS__; } } while (0)
    RUN(0, phase0a(F, ap));
    GRID_BAR();
    if (REP_K == 20) { for (int _r = 0; _r < 20; ++_r) GRID_BAR(); }
    RUN(1, modnorm_rows(F, ap->x, ap->norm1_g, 0, WSP(bf16_t, WS_XN)));
    GRID_BAR();
    RUN(2, {
        PolIn P; P.A = (const char*)(F.ws + WS_XN); P.Bt = (const char*)(F.ws + WS_BTIN); P.so.init(NTOK, NIN, F.G, F.bx);
        P.U = WSP(bf16_t, WS_U); P.BG = WSP(bf16_t, WS_BG); P.Q = WSP(bf16_t, WS_Q); P.Kk = WSP(bf16_t, WS_K); P.V = WSP(bf16_t, WS_V); P.QI = WSP(bf16_t, WS_QI); P.KI = WSP(bf16_t, WS_KI);
        P.WI = WSP(float, WS_WI); P.rope = WSP(float, WS_ROPE); P.gq = ap->q_g; P.gk = ap->k_g; P.gki = ap->ki_g;
        g8::gemm_run(F.lds, F.tid, P);
    });
    GRID_BAR();
    RUN(3, conv_phase(F, ap));
    RUN(4, indexer_phase(F));
    GRID_BAR();
    RUN(5, attn_phase(F, ap));
    GRID_BAR();
    RUN(6, {
        PolOut P; P.A = (const char*)(F.ws + WS_MIX); P.Bt = (const char*)(F.ws + WS_BTOUT); P.so.init(NTOK, DM, F.G, F.bx); P.x = ap->x; P.ada = WSP(float, WS_ADA); P.out = ap->out;
        g8::gemm_run(F.lds, F.tid, P);
    });
    GRID_BAR();
    RUN(7, modnorm_rows_bf16(F, (const bf16_t*)(ap->out + (size_t)NTOK * DM / 2), ap->norm2_g, 3072, WSP(bf16_t, WS_XN)));
    GRID_BAR();
    RUN(8, {
        PolS P; P.A = (const char*)(F.ws + WS_XN); P.W13s = (const char*)(F.ws + WS_W13) + (size_t)64 * 512 * 2048; P.Wr = (const char*)(F.ws + WS_WRT); P.G = F.G; P.c = (F.bx & 7) * (F.G >> 3) + (F.bx >> 3);
        P.HIDS = WSP(bf16_t, WS_HID); P.LOGI = WSP(float, WS_LOG);
        g8::gemm_run(F.lds, F.tid, P);
    });
    GRID_BAR();
    if (PH(9)) route_phase(F, ap);
    GRID_BAR();
    load_expert_tables(F);
    RUN(10, {
        PolG1 P; P.A = (const char*)(F.ws + WS_XN); P.W13 = (const char*)(F.ws + WS_W13); P.PAIR = WSP(int, WS_PAIR); P.HID = WSP(bf16_t, WS_HID); P.G = F.G; P.c = F.bx;
        P.tp = (const volatile LAS int*)(F.MISC + MW_TP); P.cnt = (const volatile LAS int*)(F.MISC + MW_CNT); P.tpx = (const volatile LAS int*)(F.MISC + MW_TPX);
        g8::gemm_run(F.lds, F.tid, P);
    });
    GRID_BAR();
    RUN(11, {
        PolG2 P; P.A = (const char*)(F.ws + WS_HID); P.W2 = (const char*)(F.ws + WS_W2); P.Y = WSP(unsigned char, WS_Y);
        P.G = F.G; P.c = F.bx; P.tp = (const volatile LAS int*)(F.MISC + MW_TP); P.tpx = (const volatile LAS int*)(F.MISC + MW_TPX);
        g8::gemm_run(F.lds, F.tid, P);
    });
    GRID_BAR();
    if (PH(12)) combine_phase(F, ap->out, [&]() { GRID_BAR(); });
}

extern "C" void kernel_launch(void* const* d_in, const int* in_sizes, int n_in, void* d_out, int out_size, void* d_ws, size_t ws_size, hipStream_t stream) {
    static int grid = 0;
    if (grid == 0) {
        if (n_in != 21 || out_size != NTOK * DM || ws_size < WS_END) { fprintf(stderr, "kernel_launch: unexpected problem (n_in %d, out %d, ws %zu)\n", n_in, out_size, ws_size); grid = -1; return; }
        int dev = 0, cus = 0;
        if (hipGetDevice(&dev) != hipSuccess || hipDeviceGetAttribute(&cus, hipDeviceAttributeMultiprocessorCount, dev) != hipSuccess) { grid = -1; return; }
        if (hipFuncSetAttribute((const void*)hymba_fwd, hipFuncAttributeMaxDynamicSharedMemorySize, LDS_BYTES) != hipSuccess) { fprintf(stderr, "kernel_launch: hipFuncSetAttribute failed\n"); grid = -1; return; }
        int per_cu = 0;
        if (hipOccupancyMaxActiveBlocksPerMultiprocessor(&per_cu, (const void*)hymba_fwd, NTHR, LDS_BYTES) != hipSuccess || per_cu < 1) fprintf(stderr, "kernel_launch: occupancy query says %d\n", per_cu);
        (void)hipGetLastError();
        if (cus != 256) { fprintf(stderr, "kernel_launch: built for a 256-CU device (got %d)\n", cus); grid = -1; return; }
        grid = cus;
    }
    if (grid < 0) return;
    (void)hipMemsetAsync((char*)d_ws + WS_CTL, 0, CTL_ZERO_BYTES, stream);
    Args a{};
    a.x = (const float*)d_in[0]; a.c = (const float*)d_in[1]; a.pos = (const int*)d_in[2]; a.norm1_g = (const float*)d_in[3]; a.norm2_g = (const float*)d_in[4];
    a.w_ada = (const float*)d_in[5]; a.b_ada = (const float*)d_in[6]; a.w_in = (const float*)d_in[7]; a.conv_w = (const float*)d_in[8]; a.q_g = (const float*)d_in[9];
    a.k_g = (const float*)d_in[10]; a.ki_g = (const float*)d_in[11]; a.w_out = (const float*)d_in[12]; a.w_router = (const float*)d_in[13]; a.router_bias = (const float*)d_in[14];
    a.w1 = (const float*)d_in[15]; a.w3 = (const float*)d_in[16]; a.w2 = (const float*)d_in[17]; a.ws1 = (const float*)d_in[18]; a.ws3 = (const float*)d_in[19]; a.ws2 = (const float*)d_in[20];
    a.out = (float*)d_out; a.ws = (unsigned char*)d_ws;
    hipLaunchKernelGGL(hymba_fwd, dim3(grid), dim3(NTHR), LDS_BYTES, stream, a);
}
```

```cpp
#include <hip/hip_runtime.h>
#include <cstdint>
#include <cstdio>

#define LAS __attribute__((address_space(3)))
#define GAS __attribute__((address_space(1)))
typedef unsigned short bf16_t;
typedef short bf16x8 __attribute__((ext_vector_type(8)));
typedef short s16x4 __attribute__((ext_vector_type(4)));
typedef float f32x2 __attribute__((ext_vector_type(2)));
typedef float f32x4 __attribute__((ext_vector_type(4)));
typedef float f32x16 __attribute__((ext_vector_type(16)));
typedef unsigned u32x2 __attribute__((ext_vector_type(2)));
typedef unsigned u32x4 __attribute__((ext_vector_type(4)));
typedef __bf16 bf16x2_t __attribute__((ext_vector_type(2)));

constexpr int NB = 8, SEQ = 4096, NTOK = NB * SEQ, DM = 1024;
constexpr int NIN = 3840;
constexpr int NEXP = 64;
constexpr float EPS = 1e-6f;
constexpr float LOG2E = 1.4426950408889634f;
constexpr float QSCALE = 0.125f * LOG2E;
constexpr int PAIRCAP = 32768;
constexpr int NWAVES = 8, NTHR = 512;

constexpr size_t MiB = 1u << 20;
constexpr size_t WS_CTL = 0, CTL_ZERO_BYTES = 1 * MiB;
constexpr size_t WS_ADA = 1 * MiB;
constexpr size_t WS_W2 = 2 * MiB;
constexpr size_t WS_PAIR = 35 * MiB;
constexpr size_t WS_GATE = 43 * MiB;
constexpr size_t WS_INV = 44 * MiB;
constexpr size_t WS_HID = 52 * MiB;
constexpr size_t WS_Y = 204 * MiB;
constexpr size_t WS_U = 35 * MiB, WS_BG = 67 * MiB, WS_Q = 99 * MiB, WS_K = 131 * MiB, WS_V = 163 * MiB;
constexpr size_t WS_XN = 204 * MiB;
constexpr size_t WS_W13 = 268 * MiB;
constexpr size_t WS_QI = 333 * MiB, WS_KI = 365 * MiB, WS_WI = 369 * MiB, WS_MASK = 370 * MiB, WS_MIX = 386 * MiB;
constexpr size_t WS_LOG = 450 * MiB;
constexpr size_t WS_ROPE = 458 * MiB;
constexpr size_t WS_BTIN = 460 * MiB;
constexpr size_t WS_BTOUT = 468 * MiB;
constexpr size_t WS_WRT = 470 * MiB;
constexpr size_t WS_END = 508 * MiB;
constexpr int SH_TILES = 128;
constexpr int CW_BAR = 4096, CW_CNT = 8192;
constexpr int RING_BYTES = 131072, MISC_OFF = RING_BYTES, MISC_BYTES = 16384, HIST_OFF = MISC_OFF + MISC_BYTES, LDS_BYTES = 163840;
constexpr int MW_TP = 32, MW_CNT = 128, MW_LCNT = 192, MW_BASE = 256, MW_TPX = 320;

__device__ __forceinline__ unsigned pk2(float lo, float hi) { f32x2 v = {lo, hi}; bf16x2_t b = __builtin_convertvector(v, bf16x2_t); return __builtin_bit_cast(unsigned, b); }
__device__ __forceinline__ float bf2f(unsigned short h) { return __uint_as_float((unsigned)h << 16); }
__device__ __forceinline__ float wave_sum(float v) {
#pragma unroll
    for (int o = 1; o < 64; o <<= 1) v += __shfl_xor(v, o);
    return v;
}
__device__ __forceinline__ float wave_max(float v) {
#pragma unroll
    for (int o = 1; o < 64; o <<= 1) v = fmaxf(v, __shfl_xor(v, o));
    return v;
}
__device__ __forceinline__ int wave_sum_i(int v) {
    v += __builtin_amdgcn_update_dpp(0, v, 0xB1, 0xf, 0xf, false);
    v += __builtin_amdgcn_update_dpp(0, v, 0x4E, 0xf, 0xf, false);
    v += __builtin_amdgcn_update_dpp(0, v, 0x141, 0xf, 0xf, false);
    v += __builtin_amdgcn_update_dpp(0, v, 0x140, 0xf, 0xf, false);
    return __builtin_amdgcn_readlane(v, 0) + __builtin_amdgcn_readlane(v, 16) + __builtin_amdgcn_readlane(v, 32) + __builtin_amdgcn_readlane(v, 48);
}
__device__ __forceinline__ float silu_f(float x) { return x / (1.0f + __expf(-x)); }

__host__ __device__ __forceinline__ int uc_head(int hh, int d) { return 128 * ((d >> 3) & 1) + 32 * hh + 8 * (d >> 4) + (d & 7); }
__host__ __device__ __forceinline__ int in_dest_row(int c) {
    if (c < 512) return 256 * (c >> 7) + (c & 127);
    if (c < 1024) { const int x = c - 512; return 256 * (4 + (x >> 8)) + (x & 255); }
    if (c < 1536) { const int x = c - 1024; return 256 * (x >> 7) + 128 + (x & 127); }
    if (c < 2048) { const int x = c - 1536; return 256 * (6 + (x >> 8)) + uc_head((x >> 6) & 3, x & 63); }
    if (c < 2560) { const int x = c - 2048; return 256 * (8 + (x >> 8)) + uc_head((x >> 6) & 3, x & 63); }
    if (c < 3072) { const int x = c - 2560; return 256 * (10 + (x >> 8)) + (x & 255); }
    if (c < 3584) { const int x = c - 3072; return 256 * (12 + (x >> 8)) + uc_head((x >> 6) & 3, x & 63); }
    if (c < 3648) return 256 * 14 + uc_head(0, c - 3584);
    return 256 * 14 + uc_head(1, c - 3648);
}
__host__ __device__ __forceinline__ bool in_row_has_src(int r) {
    if (r < 256 * 14) return true;
    const int uc = r & 255, bj = uc >> 7, wc = (uc >> 5) & 3, fq = (uc >> 3) & 3, d = 16 * fq + 8 * bj + (uc & 7);
    if (wc == 0) return true;
    if (wc == 1) return d < 8;
    return false;
}

namespace g8 {
constexpr int BM = 256, BK = 64, HALF = 128, HTB = HALF * BK * 2;
__host__ __device__ __forceinline__ int lds_byte(int r, int c) { const int st = (r >> 4) * 2 + (c >> 5), rr = r & 15, cc = c & 31, ob = rr * 64 + cc * 2; return st * 1024 + (ob ^ (((ob >> 9) & 1) << 5)); }
__host__ __device__ __forceinline__ void stage_rc(int b, int& R, int& C) { const int st = b / 1024, sb = b % 1024, swz = sb ^ (((sb >> 9) & 1) << 5); R = (st >> 1) * 16 + swz / 64; C = (st & 1) * 32 + (swz % 64) / 2; }
__host__ __device__ __forceinline__ int perm32(int rho) { const int n = rho >> 4, i = rho & 15; return 8 * (i >> 2) + 4 * n + (i & 3); }
struct Unit { int pm, pn, e, j; };
typedef f32x4 Acc[2][2][4][2];

constexpr int NXCD = 8, WGM = 8;
struct StaticOrder {
    int nM, nN, nwg, G, c;
    __device__ void init(int M, int N, int G_, int c_) { nM = M / BM; nN = N / BM; nwg = nM * nN; G = G_; c = c_; }
    __device__ bool next(int i, Unit& u) const {
        const long L = (long)i * G + c; if (L >= nwg) return false;
        int wgid = (int)L; { const int q = nwg / NXCD, r = nwg % NXCD, xcd = wgid % NXCD, off = wgid / NXCD; wgid = (xcd < r ? xcd * (q + 1) : r * (q + 1) + (xcd - r) * q) + off; }
        const int nig = WGM * nN, gid = wgid / nig, fm = gid * WGM, gsz = (nM - fm) < WGM ? (nM - fm) : WGM;
        u.pm = fm + ((wgid % nig) % gsz); u.pn = (wgid % nig) / gsz; u.e = 0; u.j = 0; return true;
    }
};

#define G8_SA(b, h) (((b) * 2 + (h)) * g8::HTB)
#define G8_SB(b, h) ((4 + (b) * 2 + (h)) * g8::HTB)
#define G8_STAGE(bufoff, gbase, voff) do { _Pragma("unroll") for (int _i = 0; _i < 2; ++_i) \
        __builtin_amdgcn_global_load_lds((const unsigned*)((const char*)(gbase) + (voff)[_i]), (LAS unsigned*)(lds + (bufoff) + ldsw + _i * 8192), 16, 0, 0); } while (0)
#define G8_LDA(dst, b, h) do { _Pragma("unroll") for (int m = 0; m < 4; ++m) _Pragma("unroll") for (int k = 0; k < 2; ++k) dst[m][k] = *(const LAS bf16x8*)(lds + G8_SA(b, h) + aoff + m * 2048 + k * 1024); } while (0)
#define G8_LDB(dst, b, h) do { _Pragma("unroll") for (int n = 0; n < 2; ++n) _Pragma("unroll") for (int k = 0; k < 2; ++k) dst[n][k] = *(const LAS bf16x8*)(lds + G8_SB(b, h) + boff + n * 2048 + k * 1024); } while (0)
#define G8_MMA(ai, bj, At, Bt) do { __builtin_amdgcn_s_setprio(1); _Pragma("unroll") for (int m = 0; m < 4; ++m) _Pragma("unroll") for (int n = 0; n < 2; ++n) _Pragma("unroll") for (int k = 0; k < 2; ++k) \
        acc[ai][bj][m][n] = __builtin_amdgcn_mfma_f32_16x16x32_bf16(Bt[n][k], At[m][k], acc[ai][bj][m][n], 0, 0, 0); __builtin_amdgcn_s_setprio(0); } while (0)
#define G8_WAIT_V(n) asm volatile("s_waitcnt vmcnt(" #n ")" ::: "memory")
#define G8_WAIT_VI(n) asm volatile("s_waitcnt vmcnt(%0)" :: "i"(n) : "memory")
#define G8_WAIT_L(n) asm volatile("s_waitcnt lgkmcnt(" #n ")" ::: "memory")
#define G8_BAR __builtin_amdgcn_s_barrier()
#define G8_SCHED __builtin_amdgcn_sched_barrier(0)

template <class P>
__device__ __forceinline__ void gemm_run(LAS unsigned char* lds, const int tid, const P& p) {
    const int wid = __builtin_amdgcn_readfirstlane(tid >> 6), lane = tid & 63, wr = wid >> 2, wc = wid & 3, fr = lane & 15, fq = lane >> 4;
    constexpr int K = P::K, nt = K / BK;
    int R0, C0; stage_rc(tid * 16, R0, C0);
    unsigned voffB[2];
#pragma unroll
    for (int i = 0; i < 2; ++i) { const int R = R0 + 64 * i, Rb = (R & ~31) + perm32(R & 31); voffB[i] = (unsigned)(Rb * K + C0) * 2u; }
    const unsigned colA = (unsigned)C0 * 2u;
    constexpr size_t kstep = (size_t)(BK * 2), hstepB = (size_t)HALF * K * 2;
    const unsigned ldsw = (unsigned)wid * 1024u;
    const int aoff = lds_byte(wr * 64 + fr, fq * 8), boff = lds_byte(wc * 32 + fr, fq * 8);
    const char* const Ab = p.abase();
    Unit cur, nxt; int ui = 0;
    if (!p.next(0, cur)) return;
    Acc acc;
#pragma unroll
    for (int a = 0; a < 2; ++a)
#pragma unroll
        for (int b = 0; b < 2; ++b)
#pragma unroll
            for (int m = 0; m < 4; ++m)
#pragma unroll
                for (int n = 0; n < 2; ++n) acc[a][b][m][n] = (f32x4){0.f, 0.f, 0.f, 0.f};
    bf16x8 At[4][2], B0[2][2], B1[2][2];
    unsigned roC[2][2], roN[2][2];
    p.arows(cur, R0, roC);
#pragma unroll
    for (int h = 0; h < 2; ++h)
#pragma unroll
        for (int i = 0; i < 2; ++i) roC[h][i] += colA;
    const char* cB = p.bbase(cur);
    G8_STAGE(G8_SB(0, 0), cB, voffB); G8_STAGE(G8_SB(0, 1), cB + hstepB, voffB); G8_STAGE(G8_SA(0, 0), Ab, roC[0]); G8_STAGE(G8_SA(0, 1), Ab, roC[1]);
    if (wr == 1) G8_BAR;
    G8_WAIT_V(2); G8_BAR;
    G8_STAGE(G8_SB(1, 0), cB + kstep, voffB); G8_STAGE(G8_SA(1, 0), Ab + kstep, roC[0]); G8_STAGE(G8_SB(1, 1), cB + hstepB + kstep, voffB);
    G8_WAIT_V(6); G8_BAR;
    for (;;) {
        const bool has_next = p.next(ui + 1, nxt);
        const char* nB = cB;
        if (has_next) {
            p.arows(nxt, R0, roN);
#pragma unroll
            for (int h = 0; h < 2; ++h)
#pragma unroll
                for (int i = 0; i < 2; ++i) roN[h][i] += colA;
            nB = p.bbase(nxt);
        } else {
#pragma unroll
            for (int h = 0; h < 2; ++h)
#pragma unroll
                for (int i = 0; i < 2; ++i) roN[h][i] = roC[h][i];
        }
#pragma unroll 1
        for (int t = 0; t < nt; t += 2) {
            const bool last = (t == nt - 2);
            const char* a1 = Ab + (size_t)(t + 1) * kstep;
            const char* a2 = last ? Ab : Ab + (size_t)(t + 2) * kstep; const char* b2 = last ? nB : cB + (size_t)(t + 2) * kstep;
            const char* a3 = a2 + kstep; const char* b3 = b2 + kstep;
            unsigned r2[2][2];
#pragma unroll
            for (int h = 0; h < 2; ++h)
#pragma unroll
                for (int i = 0; i < 2; ++i) r2[h][i] = last ? roN[h][i] : roC[h][i];
            unsigned rc1[2] = {roC[1][0], roC[1][1]};
            asm volatile("" : "+v"(r2[0][0]), "+v"(r2[0][1]), "+v"(r2[1][0]), "+v"(r2[1][1]), "+v"(rc1[0]), "+v"(rc1[1]));
            const bool after_epi = (P::EPI_STORES > 0) && (t == 0) && (ui > 0);
            G8_LDB(B0, 0, 0); G8_LDB(B1, 0, 1); G8_SCHED; G8_LDA(At, 0, 0); G8_STAGE(G8_SA(1, 1), a1, rc1);
            if (after_epi) G8_WAIT_VI(8 + P::EPI_STORES); else G8_WAIT_V(8);
            G8_WAIT_L(0); G8_BAR; G8_MMA(0, 0, At, B0); G8_MMA(0, 1, At, B1); G8_BAR; G8_SCHED;
            G8_LDA(At, 0, 1); G8_STAGE(G8_SB(0, 0), b2, voffB); G8_STAGE(G8_SB(0, 1), b2 + hstepB, voffB); G8_STAGE(G8_SA(0, 0), a2, r2[0]);
            if (after_epi) G8_WAIT_VI(8 + P::EPI_STORES); else G8_WAIT_V(8);
            G8_WAIT_L(0); G8_BAR; G8_MMA(1, 0, At, B0); G8_MMA(1, 1, At, B1); G8_BAR; G8_SCHED;
            G8_LDB(B0, 1, 0); G8_LDB(B1, 1, 1); G8_SCHED; G8_LDA(At, 1, 0); G8_STAGE(G8_SA(0, 1), a2, r2[1]);
            G8_WAIT_V(8); G8_WAIT_L(0); G8_BAR; G8_MMA(0, 0, At, B0); G8_MMA(0, 1, At, B1); G8_BAR; G8_SCHED;
            G8_LDA(At, 1, 1); G8_STAGE(G8_SB(1, 0), b3, voffB); G8_STAGE(G8_SB(1, 1), b3 + hstepB, voffB); G8_STAGE(G8_SA(1, 0), a3, r2[0]);
            G8_WAIT_V(8); G8_WAIT_L(0); G8_BAR; G8_MMA(1, 0, At, B0); G8_MMA(1, 1, At, B1); G8_BAR; G8_SCHED;
        }
        if (wr == 0) G8_BAR;
        p.epi(acc, cur, wr, wc, fr, fq);
        if (!has_next) break;
#pragma unroll
        for (int a = 0; a < 2; ++a)
#pragma unroll
            for (int b = 0; b < 2; ++b)
#pragma unroll
                for (int m = 0; m < 4; ++m)
#pragma unroll
                    for (int n = 0; n < 2; ++n) acc[a][b][m][n] = (f32x4){0.f, 0.f, 0.f, 0.f};
        cur = nxt; cB = nB; ++ui;
#pragma unroll
        for (int h = 0; h < 2; ++h)
#pragma unroll
            for (int i = 0; i < 2; ++i) roC[h][i] = roN[h][i];
        if (wr == 1) G8_BAR;
    }
    G8_WAIT_V(0);
    G8_BAR;
}
}

#define XB_TMO      128
#define XB_XCNT(j)  (256  + 64 * (j))
#define XB_XSUB(j)  (1280 + 64 * (j))
#define XB_XGEN(j)  (2304 + 64 * (j))
#define XB_TOP      3328
#define XB_TOPGEN   3392
#define XCD_BAR_WORDS 3456
#define XB_SPIN_CAP (1u << 18)
__device__ __forceinline__ unsigned xb_ld(unsigned* p)              { return __hip_atomic_load(p, __ATOMIC_RELAXED, __HIP_MEMORY_SCOPE_AGENT); }
__device__ __forceinline__ unsigned xb_add(unsigned* p, unsigned v) { return __hip_atomic_fetch_add(p, v, __ATOMIC_RELAXED, __HIP_MEMORY_SCOPE_AGENT); }
__device__ __forceinline__ unsigned xb_xcc_id() { return (unsigned)__builtin_amdgcn_s_getreg((3 << 11) | 20) & 0xFu; }
#define XB_SPIN(cond, bar) do { unsigned _sp = 0; while (cond) { __builtin_amdgcn_s_sleep(1); \
    if ((++_sp & 255u) == 0u) { if (xb_ld(&(bar)[XB_TMO])) break; if (_sp > XB_SPIN_CAP) { atomicAdd(&(bar)[XB_TMO], 1u); break; } } } } while (0)
struct XcdBarrier { unsigned* bar; unsigned x; volatile LAS unsigned* st; };
__device__ __forceinline__ XcdBarrier xcd_barrier_post(unsigned* bar, volatile LAS unsigned* st) {
    XcdBarrier b; b.bar = bar; b.x = xb_xcc_id(); b.st = st;
    if (threadIdx.x == 0) (void)xb_add(&bar[XB_XCNT(b.x)], 1u);
    return b;
}
__device__ __forceinline__ void xcd_barrier_complete(unsigned* bar, unsigned x, unsigned& nloc, unsigned& nx) {
    const unsigned G = gridDim.x * gridDim.y * gridDim.z;
    unsigned sum, cnt, mine, sp = 0u;
    for (;;) {
        sum = 0u; cnt = 0u; mine = 0u;
#pragma unroll
        for (unsigned j = 0; j < 16; ++j) { const unsigned c = xb_ld(&bar[XB_XCNT(j)]); sum += c; cnt += (c > 0u) ? 1u : 0u; mine = (j == x) ? c : mine; }
        if (sum == G) break;
        __builtin_amdgcn_s_sleep(1);
        if ((++sp & 255u) == 0u) { if (xb_ld(&bar[XB_TMO])) break; if (sp > XB_SPIN_CAP) { atomicAdd(&bar[XB_TMO], 1u); break; } }
    }
    nloc = mine > 0u ? mine : 1u; nx = cnt > 0u ? cnt : 1u;
}
__device__ __forceinline__ void xcd_barrier(const XcdBarrier& b) {
    asm volatile("s_waitcnt vmcnt(0)" ::: "memory");
    __syncthreads();
    if (threadIdx.x == 0) {
        unsigned* bar = b.bar;
        __builtin_amdgcn_s_waitcnt(0);
        unsigned nloc = b.st[0], nx = b.st[1];
        if (nloc == 0u) { xcd_barrier_complete(bar, b.x, nloc, nx); b.st[0] = nloc; b.st[1] = nx; }
        const unsigned old = xb_add(&bar[XB_XSUB(b.x)], 1u);
        const unsigned gen = old / nloc;
        if (old + 1u == (gen + 1u) * nloc) {
            __builtin_amdgcn_fence(__ATOMIC_RELEASE, "agent");
            asm volatile("s_waitcnt vmcnt(0)" ::: "memory");
            const unsigned og = xb_add(&bar[XB_TOP], 1u);
            const unsigned tg = og / nx;
            if (og + 1u == (tg + 1u) * nx) xb_add(&bar[XB_TOPGEN], 1u);
            else XB_SPIN(xb_ld(&bar[XB_TOPGEN]) == tg, bar);
            __builtin_amdgcn_fence(__ATOMIC_ACQUIRE, "agent");
            xb_add(&bar[XB_XGEN(b.x)], 1u);
            asm volatile("s_waitcnt vmcnt(0)" ::: "memory");
        } else {
            XB_SPIN(xb_ld(&bar[XB_XGEN(b.x)]) == gen, bar);
            __builtin_amdgcn_fence(__ATOMIC_ACQUIRE, "agent");
            asm volatile("s_waitcnt vmcnt(0)" ::: "memory");
        }
    }
    __syncthreads();
}

struct Args {
    const float* x; const float* c; const int* pos; const float* norm1_g; const float* norm2_g; const float* w_ada; const float* b_ada; const float* w_in;
    const float* conv_w; const float* q_g; const float* k_g; const float* ki_g; const float* w_out; const float* w_router; const float* router_bias;
    const float* w1; const float* w3; const float* w2; const float* ws1; const float* ws3; const float* ws2;
    float* out; unsigned char* ws;
};
typedef const __attribute__((address_space(4))) Args* ArgsP;
struct Frame {
    LAS unsigned char* lds; volatile LAS unsigned* MISC;
    int tid, lane, wave, G, bx;
    unsigned char* ws;
};
__device__ __forceinline__ ArgsP refresh(Frame& F) {
    int t = threadIdx.x; asm volatile("" : "+v"(t)); F.tid = t; F.lane = t & 63; F.wave = __builtin_amdgcn_readfirstlane(t >> 6);
    int b = blockIdx.x; asm volatile("" : "+s"(b)); F.bx = b;
    ArgsP p = (ArgsP)__builtin_amdgcn_kernarg_segment_ptr(); asm volatile("" : "+s"(p));
    F.ws = p->ws; return p;
}
#define WSP(T, off) ((T*)(F.ws + (off)))

template <class Map>
__device__ __forceinline__ void tr_item(const float* W, int N, int k0, int n0, bf16_t* WT, int ldt, LAS float* scr, int lane, Map map) {
    const int r = lane >> 3, c4 = (lane & 7) * 4;
    f32x4 v[8];
#pragma unroll
    for (int u = 0; u < 8; ++u) v[u] = (n0 + c4 < N) ? *(const f32x4*)(W + (size_t)(k0 + 8 * u + r) * N + n0 + c4) : (f32x4){0.f, 0.f, 0.f, 0.f};
#pragma unroll
    for (int u = 0; u < 8; ++u) { LAS float* d = scr + (8 * u + r) * 33 + c4; d[0] = v[u][0]; d[1] = v[u][1]; d[2] = v[u][2]; d[3] = v[u][3]; }
    asm volatile("s_waitcnt lgkmcnt(0)" ::: "memory");
    const int c = lane & 7;
#pragma unroll
    for (int j = 0; j < 4; ++j) {
        const int nl = (lane >> 3) + 8 * j, n = n0 + nl;
        if (n < N) {
            const LAS float* s = scr + (8 * c) * 33 + nl;
            u32x4 o; o.x = pk2(s[0 * 33], s[1 * 33]); o.y = pk2(s[2 * 33], s[3 * 33]); o.z = pk2(s[4 * 33], s[5 * 33]); o.w = pk2(s[6 * 33], s[7 * 33]);
            *(u32x4*)(WT + (size_t)map(n) * ldt + k0 + 8 * c) = o;
        }
    }
    asm volatile("s_waitcnt lgkmcnt(0)" ::: "memory");
}

constexpr int CW_JOB = 16384;
constexpr int NJ13 = 65 * 128, NJ13_P1 = 5120, NJ2 = 65 * 128;
__device__ __forceinline__ void w13_job(ArgsP ap, unsigned char* ws, int j, LAS float* scr, int lane) {
    const int it = (j < 128) ? 64 * 128 + j : j - 128;
    const int e = it >> 7, r = it & 127, k0 = 64 * (r >> 3), n0 = 32 * (r & 7);
    const float* s1 = (e < 64) ? ap->w1 + (size_t)e * 262144 : ap->ws1; const float* s3 = (e < 64) ? ap->w3 + (size_t)e * 262144 : ap->ws3;
    bf16_t* w13 = (bf16_t*)(ws + WS_W13);
    tr_item(s1, 256, k0, n0, w13, 1024, scr, lane, [e](int n) { return e * 512 + 256 * (n >> 7) + (n & 127); });
    tr_item(s3, 256, k0, n0, w13, 1024, scr, lane, [e](int n) { return e * 512 + 256 * (n >> 7) + 128 + (n & 127); });
}
__device__ __forceinline__ void w2_job(ArgsP ap, unsigned char* ws, int it, LAS float* scr, int lane) {
    const int e = it >> 7, r = it & 127, k0 = 64 * (r >> 5), n0 = 32 * (r & 31);
    const float* s2 = (e < 64) ? ap->w2 + (size_t)e * 262144 : ap->ws2;
    bf16_t* w2t = (bf16_t*)(ws + WS_W2);
    tr_item(s2, 1024, k0, n0, w2t, 256, scr, lane, [e](int n) { return e * 1024 + (n & ~255) + 128 * ((n >> 3) & 1) + 32 * ((n >> 6) & 3) + 8 * ((n >> 4) & 3) + (n & 7); });
}
__device__ __forceinline__ void static_jobs13(Frame& F, ArgsP ap, int slot, int nslots, int lo, int hi) {
    LAS float* scr = (LAS float*)(F.lds + F.wave * 16384);
    for (int j = lo + slot; j < hi; j += nslots) w13_job(ap, F.ws, j, scr, F.lane);
}
__device__ __forceinline__ void drain_jobs2(Frame& F, ArgsP ap, int cw, int hi) {
    unsigned* ctr = (unsigned*)(F.ws + WS_CTL) + cw;
    LAS float* scr = (LAS float*)(F.lds + F.wave * 16384);
    for (;;) {
        __syncthreads();
        if (F.tid == 0) F.MISC[16] = __hip_atomic_fetch_add(ctr, 8u, __ATOMIC_RELAXED, __HIP_MEMORY_SCOPE_AGENT);
        __syncthreads();
        const int base = __builtin_amdgcn_readfirstlane((int)F.MISC[16]);
        if (base >= hi) break;
        if (base + F.wave < hi) w2_job(ap, F.ws, base + F.wave, scr, F.lane);
    }
}

__device__ __forceinline__ void phase0a(Frame& F, ArgsP ap) {
    struct { const float *c, *w_ada, *b_ada, *w_in, *w_out, *w_router, *w1, *w3, *w2, *ws1, *ws3, *ws2; const int* pos; } a;
    a.c = ap->c; a.w_ada = ap->w_ada; a.b_ada = ap->b_ada; a.w_in = ap->w_in; a.w_out = ap->w_out; a.w_router = ap->w_router; a.w1 = ap->w1; a.w3 = ap->w3; a.w2 = ap->w2;
    a.ws1 = ap->ws1; a.ws3 = ap->ws3; a.ws2 = ap->ws2; a.pos = ap->pos;
    const int gw = F.bx * NWAVES + F.wave, NGW = F.G * NWAVES, lane = F.lane;
    for (int it = gw; it < 2048; it += NGW) {
        const int col0 = 3 * it;
        float w[16][3];
#pragma unroll
        for (int i = 0; i < 16; ++i)
#pragma unroll
            for (int j = 0; j < 3; ++j) w[i][j] = a.w_ada[(size_t)(lane + 64 * i) * 6144 + col0 + j];
        float* ada = WSP(float, WS_ADA);
        for (int b = 0; b < NB; ++b) {
            float s0 = 0.f, s1 = 0.f, s2 = 0.f;
#pragma unroll
            for (int i = 0; i < 16; ++i) { const float cv = silu_f(a.c[b * DM + lane + 64 * i]); s0 += cv * w[i][0]; s1 += cv * w[i][1]; s2 += cv * w[i][2]; }
            s0 = wave_sum(s0); s1 = wave_sum(s1); s2 = wave_sum(s2);
            if (lane == 0) { ada[b * 6144 + col0] = s0 + a.b_ada[col0]; ada[b * 6144 + col0 + 1] = s1 + a.b_ada[col0 + 1]; ada[b * 6144 + col0 + 2] = s2 + a.b_ada[col0 + 2]; }
        }
    }
    LAS float* scr = (LAS float*)(F.lds + F.wave * 16384);
    bf16_t* btin = WSP(bf16_t, WS_BTIN); bf16_t* btout = WSP(bf16_t, WS_BTOUT); bf16_t* wrt = WSP(bf16_t, WS_WRT);
    for (int it = gw; it < 16 * 115; it += NGW) tr_item(a.w_in, 3656, 64 * (it / 115), 32 * (it % 115), btin, 1024, scr, lane, [](int n) { return in_dest_row(n); });
    for (int it = gw; it < 16 * 32; it += NGW) tr_item(a.w_out, 1024, 64 * (it / 32), 32 * (it % 32), btout, 1024, scr, lane, [](int n) { return n; });
    for (int it = gw; it < 16 * 2; it += NGW) tr_item(a.w_router, 64, 64 * (it / 2), 32 * (it % 2), wrt, 1024, scr, lane, [](int n) { return n; });
    for (int it = gw; it < 256 + 192; it += NGW) {
        bf16_t* row = nullptr;
        if (it < 256) { const int r = 256 * 14 + it; if (!in_row_has_src(r)) row = btin + (size_t)r * 1024; }
        else row = wrt + (size_t)(64 + it - 256) * 1024;
        if (row) { u32x4 z = {0u, 0u, 0u, 0u}; *(u32x4*)(row + lane * 8) = z; *(u32x4*)(row + 512 + lane * 8) = z; }
    }
    {
        const float invf[8] = {1.0f, 0.1939227432012558f, 0.03760603070259094f, 0.007292664609849453f, 0.0014142135623842478f, 0.00027424818836152554f, 5.3182957344688475e-05f, 1.0313385246263351e-05f};
        float* rope = WSP(float, WS_ROPE);
        for (int it = F.bx * NTHR + F.tid; it < NTOK * 8; it += F.G * NTHR) {
            const int tok = it >> 3, i = it & 7;
            float fr = 1.0f;
#pragma unroll
            for (int k = 0; k < 8; ++k) fr = (i == k) ? invf[k] : fr;
            const float ang = (float)a.pos[tok] * fr;
            const float kk = rintf(ang * 0.15915494309189535f);
            float r = fmaf(-kk, 6.2831854820251465f, ang); r = fmaf(-kk, -1.7484555314695172e-07f, r);
            rope[tok * 16 + i] = cosf(r); rope[tok * 16 + 8 + i] = sinf(r);
        }
    }
}

__device__ __forceinline__ void modnorm_rows(Frame& F, const float* X, const float* g, int ada_shift_off, bf16_t* O) {
    const int gw = F.bx * NWAVES + F.wave, NGW = F.G * NWAVES, lane = F.lane;
    const float* ada = WSP(float, WS_ADA);
    for (int m = gw; m < NTOK; m += 2 * NGW) {
        const int m2 = m + NGW;
        const f32x4* xr = (const f32x4*)(X + (size_t)m * DM) + lane; const f32x4* xr2 = (const f32x4*)(X + (size_t)m2 * DM) + lane;
        f32x4 v[4], w[4]; float s = 0.f, s2 = 0.f;
#pragma unroll
        for (int j = 0; j < 4; ++j) { v[j] = xr[64 * j]; w[j] = xr2[64 * j]; }
#pragma unroll
        for (int j = 0; j < 4; ++j) { s += (v[j].x * v[j].x + v[j].y * v[j].y) + (v[j].z * v[j].z + v[j].w * v[j].w); s2 += (w[j].x * w[j].x + w[j].y * w[j].y) + (w[j].z * w[j].z + w[j].w * w[j].w); }
        const float rstd = rsqrtf(wave_sum(s) * (1.f / DM) + EPS), rstd2 = rsqrtf(wave_sum(s2) * (1.f / DM) + EPS);
        u32x2* o8 = (u32x2*)(O + (size_t)m * DM) + lane; u32x2* o82 = (u32x2*)(O + (size_t)m2 * DM) + lane;
        const float* ab = ada + (m >> 12) * 6144 + ada_shift_off; const float* ab2 = ada + (m2 >> 12) * 6144 + ada_shift_off;
#pragma unroll
        for (int j = 0; j < 4; ++j) {
            const f32x4 gg = ((const f32x4*)g)[lane + 64 * j];
            const f32x4 sh = ((const f32x4*)ab)[lane + 64 * j], sc = ((const f32x4*)(ab + 1024))[lane + 64 * j];
            const f32x4 sh2 = ((const f32x4*)ab2)[lane + 64 * j], sc2 = ((const f32x4*)(ab2 + 1024))[lane + 64 * j];
            const f32x4 h = (v[j] * rstd) * gg * (sc + 1.0f) + sh, h2 = (w[j] * rstd2) * gg * (sc2 + 1.0f) + sh2;
            u32x2 a; a.x = pk2(h.x, h.y); a.y = pk2(h.z, h.w); o8[64 * j] = a;
            u32x2 b; b.x = pk2(h2.x, h2.y); b.y = pk2(h2.z, h2.w); o82[64 * j] = b;
        }
    }
}

__device__ __forceinline__ void modnorm_rows_bf16(Frame& F, const bf16_t* X, const float* g, int ada_shift_off, bf16_t* O) {
    const int gw = F.bx * NWAVES + F.wave, NGW = F.G * NWAVES, lane = F.lane;
    const float* ada = WSP(float, WS_ADA);
    for (int m = gw; m < NTOK; m += 2 * NGW) {
        const int m2 = m + NGW;
        const u32x2* xr = (const u32x2*)(X + (size_t)m * DM) + lane; const u32x2* xr2 = (const u32x2*)(X + (size_t)m2 * DM) + lane;
        u32x2 a[4], b[4];
#pragma unroll
        for (int j = 0; j < 4; ++j) { a[j] = xr[64 * j]; b[j] = xr2[64 * j]; }
        f32x4 v[4], w[4]; float s = 0.f, s2 = 0.f;
#pragma unroll
        for (int j = 0; j < 4; ++j) {
            v[j] = (f32x4){__uint_as_float(a[j].x << 16), __uint_as_float(a[j].x & 0xffff0000u), __uint_as_float(a[j].y << 16), __uint_as_float(a[j].y & 0xffff0000u)};
            w[j] = (f32x4){__uint_as_float(b[j].x << 16), __uint_as_float(b[j].x & 0xffff0000u), __uint_as_float(b[j].y << 16), __uint_as_float(b[j].y & 0xffff0000u)};
            s += (v[j].x * v[j].x + v[j].y * v[j].y) + (v[j].z * v[j].z + v[j].w * v[j].w); s2 += (w[j].x * w[j].x + w[j].y * w[j].y) + (w[j].z * w[j].z + w[j].w * w[j].w);
        }
        const float rstd = rsqrtf(wave_sum(s) * (1.f / DM) + EPS), rstd2 = rsqrtf(wave_sum(s2) * (1.f / DM) + EPS);
        u32x2* o8 = (u32x2*)(O + (size_t)m * DM) + lane; u32x2* o82 = (u32x2*)(O + (size_t)m2 * DM) + lane;
        const float* ab = ada + (m >> 12) * 6144 + ada_shift_off; const float* ab2 = ada + (m2 >> 12) * 6144 + ada_shift_off;
#pragma unroll
        for (int j = 0; j < 4; ++j) {
            const f32x4 gg = ((const f32x4*)g)[lane + 64 * j];
            const f32x4 sh = ((const f32x4*)ab)[lane + 64 * j], sc = ((const f32x4*)(ab + 1024))[lane + 64 * j];
            const f32x4 sh2 = ((const f32x4*)ab2)[lane + 64 * j], sc2 = ((const f32x4*)(ab2 + 1024))[lane + 64 * j];
            const f32x4 h = (v[j] * rstd) * gg * (sc + 1.0f) + sh, h2 = (w[j] * rstd2) * gg * (sc2 + 1.0f) + sh2;
            u32x2 p; p.x = pk2(h.x, h.y); p.y = pk2(h.z, h.w); o8[64 * j] = p;
            u32x2 q; q.x = pk2(h2.x, h2.y); q.y = pk2(h2.z, h2.w); o82[64 * j] = q;
        }
    }
}

using g8::Unit; using g8::Acc;
__device__ __forceinline__ u32x4 pack8(const f32x4& a, const f32x4& b) { u32x4 w; w.x = pk2(a[0], a[1]); w.y = pk2(a[2], a[3]); w.z = pk2(b[0], b[1]); w.w = pk2(b[2], b[3]); return w; }

struct PolIn {
    static constexpr int K = 1024; static constexpr int EPI_STORES = 0;
    const char* A; const char* Bt; g8::StaticOrder so;
    bf16_t *U, *BG, *Q, *Kk, *V, *QI, *KI; float* WI; const float* rope; const float *gq, *gk, *gki;
    __device__ __forceinline__ const char* abase() const { return A; }
    __device__ __forceinline__ bool next(int i, Unit& u) const { return so.next(i, u); }
    __device__ __forceinline__ void arows(const Unit& u, int R0, unsigned (&ro)[2][2]) const {
#pragma unroll
        for (int h = 0; h < 2; ++h)
#pragma unroll
            for (int i = 0; i < 2; ++i) ro[h][i] = (unsigned)(256 * u.pm + 128 * h + 64 * i + R0) * 2048u;
    }
    __device__ __forceinline__ const char* bbase(const Unit& u) const { return Bt + (size_t)u.pn * 256 * 2048; }
    __device__ __forceinline__ void head_row(f32x4 a00, f32x4 a01, f32x4 a10, f32x4 a11, int row, int fq, const float* g, bool norm, float scale, bf16_t* dst) const {
        if (norm) {
            float ss = (a00[0] * a00[0] + a00[1] * a00[1]) + (a00[2] * a00[2] + a00[3] * a00[3]) + (a01[0] * a01[0] + a01[1] * a01[1]) + (a01[2] * a01[2] + a01[3] * a01[3])
                     + (a10[0] * a10[0] + a10[1] * a10[1]) + (a10[2] * a10[2] + a10[3] * a10[3]) + (a11[0] * a11[0] + a11[1] * a11[1]) + (a11[2] * a11[2] + a11[3] * a11[3]);
            ss += __shfl_xor(ss, 16); ss += __shfl_xor(ss, 32);
            const float rstd = rsqrtf(ss * (1.f / 64.f) + EPS);
            const f32x4* gp = (const f32x4*)(g + 16 * fq);
            a00 = a00 * rstd * gp[0]; a01 = a01 * rstd * gp[1]; a10 = a10 * rstd * gp[2]; a11 = a11 * rstd * gp[3];
        }
        if (fq == 0) {
            const f32x4* rp = (const f32x4*)(rope + (size_t)row * 16);
            const f32x4 c0 = rp[0], c1 = rp[1], s0 = rp[2], s1 = rp[3];
            const f32x4 x0 = a00, x1 = a01, y0 = a10, y1 = a11;
            a00 = x0 * c0 - y0 * s0; a10 = y0 * c0 + x0 * s0;
            a01 = x1 * c1 - y1 * s1; a11 = y1 * c1 + x1 * s1;
        }
        a00 = a00 * scale; a01 = a01 * scale; a10 = a10 * scale; a11 = a11 * scale;
        *(u32x4*)(dst + 16 * fq) = pack8(a00, a01);
        *(u32x4*)(dst + 16 * fq + 8) = pack8(a10, a11);
    }
    __device__ __forceinline__ void epi(const Acc& acc, const Unit& u, int wr, int wc, int fr, int fq) const {
        const int pn = u.pn;
#pragma unroll
        for (int ai = 0; ai < 2; ++ai)
#pragma unroll
            for (int m = 0; m < 4; ++m) {
                const int row = 256 * u.pm + 128 * ai + 64 * wr + 16 * m + fr;
                const f32x4 a00 = acc[ai][0][m][0], a01 = acc[ai][0][m][1], a10 = acc[ai][1][m][0], a11 = acc[ai][1][m][1];
                const int cc = 32 * wc + 8 * fq;
                if (pn < 4) {
                    *(u32x4*)(U + (size_t)row * 512 + 128 * pn + cc) = pack8(a00 * a10, a01 * a11);
                } else if (pn < 6) {
                    bf16_t* d = BG + (size_t)row * 512 + 256 * (pn - 4) + cc;
                    *(u32x4*)d = pack8(a00, a01); *(u32x4*)(d + 128) = pack8(a10, a11);
                } else if (pn < 8) {
                    head_row(a00, a01, a10, a11, row, fq, gq, true, QSCALE, Q + (size_t)row * 512 + (4 * (pn - 6) + wc) * 64);
                } else if (pn < 10) {
                    head_row(a00, a01, a10, a11, row, fq, gk, true, 1.0f, Kk + (size_t)row * 512 + (4 * (pn - 8) + wc) * 64);
                } else if (pn < 12) {
                    bf16_t* d = V + (size_t)row * 512 + 256 * (pn - 10) + cc;
                    *(u32x4*)d = pack8(a00, a01); *(u32x4*)(d + 128) = pack8(a10, a11);
                } else if (pn < 14) {
                    head_row(a00, a01, a10, a11, row, fq, gq, false, 1.0f, QI + (size_t)row * 512 + (4 * (pn - 12) + wc) * 64);
                } else {
                    if (wc == 0) head_row(a00, a01, a10, a11, row, fq, gki, true, 1.0f, KI + (size_t)row * 64);
                    else if (wc == 1 && fq == 0) { *(f32x4*)(WI + (size_t)row * 8) = a00; *(f32x4*)(WI + (size_t)row * 8 + 4) = a01; }
                }
            }
    }
};

struct PolOut {
    static constexpr int K = 1024; static constexpr int EPI_STORES = 0;
    const char* A; const char* Bt; g8::StaticOrder so; const float* x; const float* ada; float* out;
    __device__ __forceinline__ const char* abase() const { return A; }
    __device__ __forceinline__ bool next(int i, Unit& u) const { return so.next(i, u); }
    __device__ __forceinline__ void arows(const Unit& u, int R0, unsigned (&ro)[2][2]) const {
#pragma unroll
        for (int h = 0; h < 2; ++h)
#pragma unroll
            for (int i = 0; i < 2; ++i) ro[h][i] = (unsigned)(256 * u.pm + 128 * h + 64 * i + R0) * 2048u;
    }
    __device__ __forceinline__ const char* bbase(const Unit& u) const { return Bt + (size_t)u.pn * 256 * 2048; }
    __device__ __forceinline__ void epi(const Acc& acc, const Unit& u, int wr, int wc, int fr, int fq) const {
        const int b = u.pm >> 4;
        const float* gate = ada + b * 6144 + 2048;
        bf16_t* x1b = (bf16_t*)(out + (size_t)NTOK * DM / 2);
#pragma unroll
        for (int bj = 0; bj < 2; ++bj) {
            const int col = 256 * u.pn + 128 * bj + 32 * wc + 8 * fq;
            const f32x4 g0 = *(const f32x4*)(gate + col), g1 = *(const f32x4*)(gate + col + 4);
#pragma unroll
            for (int ai = 0; ai < 2; ++ai)
#pragma unroll
                for (int m = 0; m < 4; ++m) {
                    const size_t off = (size_t)(256 * u.pm + 128 * ai + 64 * wr + 16 * m + fr) * DM + col;
                    const f32x4 x0 = *(const f32x4*)(x + off), x1 = *(const f32x4*)(x + off + 4);
                    *(u32x4*)(x1b + off) = pack8(x0 + g0 * acc[ai][bj][m][0], x1 + g1 * acc[ai][bj][m][1]);
                }
        }
    }
};

__device__ __forceinline__ f32x4 swiglu4(const f32x4& a, const f32x4& b) {
    f32x4 r;
#pragma unroll
    for (int i = 0; i < 4; ++i) r[i] = a[i] * __builtin_amdgcn_rcpf(1.0f + __builtin_amdgcn_exp2f(-a[i] * LOG2E)) * b[i];
    return r;
}

struct PolS {
    static constexpr int K = 1024; static constexpr int EPI_STORES = 0;
    const char* A; const char* W13s; const char* Wr; int G, c; bf16_t* HIDS; float* LOGI;
    __device__ __forceinline__ const char* abase() const { return A; }
    __device__ __forceinline__ bool next(int i, Unit& u) const { const int L = i * G + c; if (L >= 384) return false; u.pm = L / 3; u.pn = L % 3; u.e = 0; u.j = 0; return true; }
    __device__ __forceinline__ void arows(const Unit& u, int R0, unsigned (&ro)[2][2]) const {
#pragma unroll
        for (int h = 0; h < 2; ++h)
#pragma unroll
            for (int i = 0; i < 2; ++i) ro[h][i] = (unsigned)(256 * u.pm + 128 * h + 64 * i + R0) * 2048u;
    }
    __device__ __forceinline__ const char* bbase(const Unit& u) const { return u.pn < 2 ? W13s + (size_t)u.pn * 256 * 2048 : Wr; }
    __device__ __forceinline__ void epi(const Acc& acc, const Unit& u, int wr, int wc, int fr, int fq) const {
#pragma unroll
        for (int ai = 0; ai < 2; ++ai)
#pragma unroll
            for (int m = 0; m < 4; ++m) {
                const int row = 256 * u.pm + 128 * ai + 64 * wr + 16 * m + fr;
                if (u.pn < 2) {
                    *(u32x4*)(HIDS + (size_t)row * 256 + 128 * u.pn + 32 * wc + 8 * fq) = pack8(swiglu4(acc[ai][0][m][0], acc[ai][1][m][0]), swiglu4(acc[ai][0][m][1], acc[ai][1][m][1]));
                } else if (wc < 2) {
                    float* d = LOGI + (size_t)row * 64 + 32 * wc + 8 * fq;
                    *(f32x4*)d = acc[ai][0][m][0]; *(f32x4*)(d + 4) = acc[ai][0][m][1];
                }
            }
    }
};

struct PolG1 {
    static constexpr int K = 1024; static constexpr int EPI_STORES = 0;
    const char* A; const char* W13; const int* PAIR; bf16_t* HID; int G, c; const volatile LAS int* tp; const volatile LAS int* cnt; const volatile LAS int* tpx;
    __device__ __forceinline__ const char* abase() const { return A; }
    __device__ __forceinline__ bool next(int i, Unit& u) const {
        const int L = i * 32 + (c >> 3); if (L >= 2 * __builtin_amdgcn_readfirstlane(tpx[8])) return false;
        const int tl = L >> 1; int k = 0;
        while (__builtin_amdgcn_readfirstlane(tpx[k + 1]) <= tl) ++k;
        const int e = (c & 7) + 8 * k, j = tl - __builtin_amdgcn_readfirstlane(tpx[k]);
        u.pm = __builtin_amdgcn_readfirstlane(tp[e]) + j; u.pn = L & 1; u.e = e; u.j = j; return true;
    }
    __device__ __forceinline__ void arows(const Unit& u, int R0, unsigned (&ro)[2][2]) const {
        const int ce = cnt[u.e];
#pragma unroll
        for (int h = 0; h < 2; ++h)
#pragma unroll
            for (int i = 0; i < 2; ++i) { const int pos = 256 * u.j + 128 * h + 64 * i + R0; const int p = (pos < ce) ? PAIR[u.e * PAIRCAP + pos] : 0; ro[h][i] = (unsigned)(p >> 3) * 2048u; }
    }
    __device__ __forceinline__ const char* bbase(const Unit& u) const { return W13 + ((size_t)u.e * 512 + 256 * u.pn) * 2048; }
    __device__ __forceinline__ void epi(const Acc& acc, const Unit& u, int wr, int wc, int fr, int fq) const {
        const int valid = cnt[u.e] - 256 * u.j;
#pragma unroll
        for (int ai = 0; ai < 2; ++ai)
#pragma unroll
            for (int m = 0; m < 4; ++m) {
                const int r = 128 * ai + 64 * wr + 16 * m + fr;
                if (r < valid)
                    *(u32x4*)(HID + (size_t)(256 * u.pm + r) * 256 + 128 * u.pn + 32 * wc + 8 * fq) = pack8(swiglu4(acc[ai][0][m][0], acc[ai][1][m][0]), swiglu4(acc[ai][0][m][1], acc[ai][1][m][1]));
            }
    }
};

struct PolG2 {
    static constexpr int K = 256; static constexpr int EPI_STORES = 8;
    const char* A; const char* W2; unsigned char* Y; int G, c; const volatile LAS int* tp; const volatile LAS int* tpx;
    __device__ __forceinline__ const char* abase() const { return A; }
    __device__ __forceinline__ bool next(int i, Unit& u) const {
        const int L = i * 32 + (c >> 3); if (L >= 4 * (16 + __builtin_amdgcn_readfirstlane(tpx[8]))) return false;
        const int tl = L >> 2; u.pn = L & 3; u.j = 0;
        if (tl < 16) { u.pm = 16 * (c & 7) + tl; u.e = 64; return true; }
        int k = 0;
        while (__builtin_amdgcn_readfirstlane(tpx[k + 1]) <= tl - 16) ++k;
        const int e = (c & 7) + 8 * k;
        u.pm = __builtin_amdgcn_readfirstlane(tp[e]) + (tl - 16 - __builtin_amdgcn_readfirstlane(tpx[k])); u.e = e; return true;
    }
    __device__ __forceinline__ void arows(const Unit& u, int R0, unsigned (&ro)[2][2]) const {
#pragma unroll
        for (int h = 0; h < 2; ++h)
#pragma unroll
            for (int i = 0; i < 2; ++i) ro[h][i] = (unsigned)(256 * u.pm + 128 * h + 64 * i + R0) * 512u;
    }
    __device__ __forceinline__ const char* bbase(const Unit& u) const { return W2 + ((size_t)u.e * 1024 + 256 * u.pn) * 512; }
    __device__ __forceinline__ void epi(const Acc& acc, const Unit& u, int wr, int wc, int fr, int fq) const {
#pragma unroll
        for (int ai = 0; ai < 2; ++ai)
#pragma unroll
            for (int m = 0; m < 4; ++m) {
                const f32x4 a = acc[ai][0][m][0] * 16.0f, b = acc[ai][0][m][1] * 16.0f, c2 = acc[ai][1][m][0] * 16.0f, d = acc[ai][1][m][1] * 16.0f;
                u32x4 w;
                w.x = (unsigned)__builtin_amdgcn_cvt_pk_fp8_f32(a[2], a[3], __builtin_amdgcn_cvt_pk_fp8_f32(a[0], a[1], 0, false), true);
                w.y = (unsigned)__builtin_amdgcn_cvt_pk_fp8_f32(b[2], b[3], __builtin_amdgcn_cvt_pk_fp8_f32(b[0], b[1], 0, false), true);
                w.z = (unsigned)__builtin_amdgcn_cvt_pk_fp8_f32(c2[2], c2[3], __builtin_amdgcn_cvt_pk_fp8_f32(c2[0], c2[1], 0, false), true);
                w.w = (unsigned)__builtin_amdgcn_cvt_pk_fp8_f32(d[2], d[3], __builtin_amdgcn_cvt_pk_fp8_f32(d[0], d[1], 0, false), true);
                *(u32x4*)(Y + (size_t)(256 * u.pm + 128 * ai + 64 * wr + 16 * m + fr) * 1024 + 256 * u.pn + 64 * wc + 16 * fq) = w;
            }
    }
};

__device__ __forceinline__ void acc_fp8x16(f32x4 (&s)[4], const u32x4& w, float g) {
#pragma unroll
    for (int i = 0; i < 4; ++i) {
        const f32x2 lo = __builtin_amdgcn_cvt_pk_f32_fp8((int)w[i], false), hi = __builtin_amdgcn_cvt_pk_f32_fp8((int)w[i], true);
        s[i][0] += g * lo[0]; s[i][1] += g * lo[1]; s[i][2] += g * hi[0]; s[i][3] += g * hi[1];
    }
}
__device__ __forceinline__ void combine_token(const unsigned char* Y, const float* ada, const volatile LAS int* tp, float* out, int t, int lane, int meta, const u32x4& xa, const u32x4& xb) {
    const int row_own = 256 * tp[(meta >> 15) & 63] + (meta & (PAIRCAP - 1));
    u32x4 w[9]; float g[8];
    w[8] = *(const u32x4*)(Y + (size_t)t * 1024 + lane * 16);
#pragma unroll
    for (int k = 0; k < 8; ++k) {
        const int row = __builtin_amdgcn_readlane(row_own, k); g[k] = __int_as_float(__builtin_amdgcn_readlane(meta, 8 + k)) * (1.0f / 16.0f);
        w[k] = *(const u32x4*)(Y + (size_t)row * 1024 + lane * 16);
    }
    float* op = out + (size_t)t * DM + lane * 16;
    const float* gp = ada + (t >> 12) * 6144 + 5120 + lane * 16;
    f32x4 x[4], gg[4], s[4];
    x[0] = (f32x4){__uint_as_float(xa.x << 16), __uint_as_float(xa.x & 0xffff0000u), __uint_as_float(xa.y << 16), __uint_as_float(xa.y & 0xffff0000u)};
    x[1] = (f32x4){__uint_as_float(xa.z << 16), __uint_as_float(xa.z & 0xffff0000u), __uint_as_float(xa.w << 16), __uint_as_float(xa.w & 0xffff0000u)};
    x[2] = (f32x4){__uint_as_float(xb.x << 16), __uint_as_float(xb.x & 0xffff0000u), __uint_as_float(xb.y << 16), __uint_as_float(xb.y & 0xffff0000u)};
    x[3] = (f32x4){__uint_as_float(xb.z << 16), __uint_as_float(xb.z & 0xffff0000u), __uint_as_float(xb.w << 16), __uint_as_float(xb.w & 0xffff0000u)};
#pragma unroll
    for (int i = 0; i < 4; ++i) { gg[i] = *(const f32x4*)(gp + 4 * i); s[i] = (f32x4){0.f, 0.f, 0.f, 0.f}; }
    acc_fp8x16(s, w[8], 1.0f / 16.0f);
#pragma unroll
    for (int k = 0; k < 8; ++k) acc_fp8x16(s, w[k], g[k]);
#pragma unroll
    for (int i = 0; i < 4; ++i) *(f32x4*)(op + 4 * i) = x[i] + gg[i] * s[i];
}
template <class Bar>
__device__ __forceinline__ void combine_phase(Frame& F, float* out, Bar&& grid_bar) {
    const unsigned char* Y = WSP(unsigned char, WS_Y); const float* ada = WSP(float, WS_ADA); const int* INV = WSP(int, WS_INV); const int* GATEI = WSP(int, WS_GATE);
    const volatile LAS int* tp = (const volatile LAS int*)(F.MISC + MW_TP);
    const bf16_t* x1b = (const bf16_t*)(out + (size_t)NTOK * DM / 2);
    int gw = F.bx * NWAVES + F.wave, NGW = F.G * NWAVES, lane = F.lane;
    auto fetch_meta = [&](int t) -> int { int v = 0; if (lane < 16) v = (lane < 8) ? INV[t * 8 + lane] : GATEI[t * 8 + lane - 8]; return v; };
    constexpr int NH = NTOK / 2;
    {
        int t = gw, meta = fetch_meta(t);
        for (; t < NH; t += NGW) {
            const u32x4 xa = *(const u32x4*)(x1b + (size_t)t * DM + lane * 16), xb = *(const u32x4*)(x1b + (size_t)t * DM + lane * 16 + 8);
            const int mnext = (t + NGW < NH) ? fetch_meta(t + NGW) : 0;
            combine_token(Y, ada, tp, out, t, lane, meta, xa, xb);
            meta = mnext;
        }
    }
    grid_bar();
    gw = F.bx * NWAVES + F.wave; lane = F.lane;
    u32x4 xa[8], xb[8];
#pragma unroll
    for (int i = 0; i < 8; ++i) { const int t = NH + gw + i * NGW; xa[i] = *(const u32x4*)(x1b + (size_t)t * DM + lane * 16); xb[i] = *(const u32x4*)(x1b + (size_t)t * DM + lane * 16 + 8); }
    asm volatile("" :: "v"(xa[0]), "v"(xa[1]), "v"(xa[2]), "v"(xa[3]), "v"(xa[4]), "v"(xa[5]), "v"(xa[6]), "v"(xa[7]), "v"(xb[0]), "v"(xb[1]), "v"(xb[2]), "v"(xb[3]), "v"(xb[4]), "v"(xb[5]), "v"(xb[6]), "v"(xb[7]));
    grid_bar();
    gw = F.bx * NWAVES + F.wave; lane = F.lane;
    {
        int meta = fetch_meta(NH + gw);
#pragma unroll
        for (int i = 0; i < 8; ++i) {
            const int t = NH + gw + i * NGW;
            const int mnext = (i < 7) ? fetch_meta(t + NGW) : 0;
            combine_token(Y, ada, tp, out, t, lane, meta, xa[i], xb[i]);
            meta = mnext;
        }
    }
}

struct ConvIn { u32x4 u0, u1, u2, bg; };
__device__ __forceinline__ ConvIn conv_load(const bf16_t* U, const bf16_t* BG, int it) {
    const int tok = it >> 6, c0 = (it & 63) * 8, t = tok & (SEQ - 1);
    ConvIn r; const u32x4 z = {0u, 0u, 0u, 0u};
    r.u2 = *(const u32x4*)(U + (size_t)tok * 512 + c0);
    r.u1 = (t >= 1) ? *(const u32x4*)(U + (size_t)(tok - 1) * 512 + c0) : z;
    r.u0 = (t >= 2) ? *(const u32x4*)(U + (size_t)(tok - 2) * 512 + c0) : z;
    r.bg = *(const u32x4*)(BG + (size_t)tok * 512 + c0);
    return r;
}
__device__ __forceinline__ void conv_store(const ConvIn& in, const float* conv_w, bf16_t* MIX, int it) {
    const int tok = it >> 6, c0 = (it & 63) * 8;
    float r[8];
#pragma unroll
    for (int j = 0; j < 8; ++j) {
        const int w = j >> 1;
        const float f0 = __uint_as_float((j & 1) ? (in.u0[w] & 0xffff0000u) : (in.u0[w] << 16));
        const float f1 = __uint_as_float((j & 1) ? (in.u1[w] & 0xffff0000u) : (in.u1[w] << 16));
        const float f2 = __uint_as_float((j & 1) ? (in.u2[w] & 0xffff0000u) : (in.u2[w] << 16));
        const float fb = __uint_as_float((j & 1) ? (in.bg[w] & 0xffff0000u) : (in.bg[w] << 16));
        r[j] = fb * (conv_w[c0 + j] * f0 + conv_w[512 + c0 + j] * f1 + conv_w[1024 + c0 + j] * f2);
    }
    u32x4 o; o.x = pk2(r[0], r[1]); o.y = pk2(r[2], r[3]); o.z = pk2(r[4], r[5]); o.w = pk2(r[6], r[7]);
    *(u32x4*)(MIX + (size_t)tok * 1024 + c0) = o;
}
__device__ __forceinline__ void conv_phase(Frame& F, ArgsP ap) {
    const float* conv_w = ap->conv_w;
    const bf16_t* U = WSP(bf16_t, WS_U); const bf16_t* BG = WSP(bf16_t, WS_BG); bf16_t* MIX = WSP(bf16_t, WS_MIX);
    const int stride = F.G * NTHR;
    for (int it = F.bx * NTHR + F.tid; it < NTOK * 64; it += 4 * stride) {
        const ConvIn a = conv_load(U, BG, it), b = conv_load(U, BG, it + stride), c = conv_load(U, BG, it + 2 * stride), d = conv_load(U, BG, it + 3 * stride);
        conv_store(a, conv_w, MIX, it); conv_store(b, conv_w, MIX, it + stride); conv_store(c, conv_w, MIX, it + 2 * stride); conv_store(d, conv_w, MIX, it + 3 * stride);
    }
}

__device__ __forceinline__ void indexer_unit(Frame& F, int b, int qblk) {
    const int lane = F.lane, wid = F.wave, q0 = qblk * 16, nsteps = qblk + 1;
    const bf16_t* QI = WSP(bf16_t, WS_QI); const bf16_t* KI = WSP(bf16_t, WS_KI); const float* WI = WSP(float, WS_WI);
    unsigned long long* MASK = WSP(unsigned long long, WS_MASK);
    LAS unsigned short* sc16 = (LAS unsigned short*)F.lds;
    const int g = lane >> 4, c = lane & 15;
    LAS unsigned* hist = (LAS unsigned*)(F.lds + HIST_OFF);
    { LAS u32x4* hz = (LAS u32x4*)hist; hz[F.tid] = (u32x4){0u, 0u, 0u, 0u}; hz[F.tid + NTHR] = (u32x4){0u, 0u, 0u, 0u}; }
    __syncthreads();
    {
        bf16x8 afr[8][2];
        const bf16_t* qb = QI + (size_t)(b * SEQ + q0 + c) * 512 + 8 * g;
#pragma unroll
        for (int h = 0; h < 8; ++h)
#pragma unroll
            for (int ks = 0; ks < 2; ++ks) afr[h][ks] = *(const bf16x8*)(qb + h * 64 + ks * 32);
        f32x4 wv[4][2];
#pragma unroll
        for (int j = 0; j < 4; ++j) { const float* wp = WI + (size_t)(b * SEQ + q0 + 4 * g + j) * 8; wv[j][0] = *(const f32x4*)wp; wv[j][1] = *(const f32x4*)(wp + 4); }
        const bf16_t* kb = KI + (size_t)(b * SEQ + c) * 64 + 8 * g;
        bf16x8 kA0, kA1, kB0, kB1;
        float big_ = __builtin_inff(); asm volatile("" : "+v"(big_));
#define IX_LOAD(X0, X1, st) do { const int st_ = ((st) < nsteps) ? (st) : 0; X0 = *(const bf16x8*)(kb + (size_t)st_ * 1024); X1 = *(const bf16x8*)(kb + (size_t)st_ * 1024 + 32); } while (0)
#define IX_STEP(X0, X1, st) do { { \
            float sc[4] = {0.f, 0.f, 0.f, 0.f}; \
            _Pragma("unroll") for (int h = 0; h < 8; ++h) { \
                f32x4 d = {0.f, 0.f, 0.f, 0.f}; \
                d = __builtin_amdgcn_mfma_f32_16x16x32_bf16(afr[h][0], X0, d, 0, 0, 0); \
                d = __builtin_amdgcn_mfma_f32_16x16x32_bf16(afr[h][1], X1, d, 0, 0, 0); \
                _Pragma("unroll") for (int j = 0; j < 4; ++j) sc[j] = fmaf(__builtin_amdgcn_fmed3f(d[j], 0.f, big_), wv[j][h >> 2][h & 3], sc[j]); } \
            _Pragma("unroll") for (int j = 0; j < 4; ++j) { \
                const float v = __builtin_amdgcn_fmed3f(sc[j] * 256.0f + 32768.5f, 1.0f, 65535.0f); \
                const unsigned k16_ = (unsigned)(int)v; \
                sc16[((st) < nsteps) ? ((4 * g + j) * 4096 + (st) * 16 + c) : (65536 + 4096 + lane)] = (unsigned short)k16_; \
                if ((st) * 16 + c <= q0 + 4 * g + j) __hip_atomic_fetch_add(hist + (4 * g + j) * 256 + (k16_ >> 8), 1u << ((k16_ >> 3) & 16), __ATOMIC_RELAXED, __HIP_MEMORY_SCOPE_WORKGROUP); } } } while (0)
        IX_LOAD(kA0, kA1, wid); IX_LOAD(kB0, kB1, wid + 8);
        for (int s = wid; s < nsteps; s += 16) {
            IX_STEP(kA0, kA1, s);     IX_LOAD(kA0, kA1, s + 16);
            IX_STEP(kB0, kB1, s + 8); IX_LOAD(kB0, kB1, s + 24);
        }
#undef IX_LOAD
#undef IX_STEP
    }
    __syncthreads();
    for (int qq = 2 * wid; qq < 2 * wid + 2; ++qq) {
        const int q = q0 + qq, n = q + 1, ngrp = (q >> 9) + 1;
        unsigned pk[32];
#pragma unroll
        for (int j = 0; j < 32; ++j) {
            pk[j] = 0u;
            if ((j >> 2) < ngrp) {
                const int ka = 128 * j + lane, kb2 = ka + 64;
                const unsigned va = sc16[qq * 4096 + ka], vb = sc16[qq * 4096 + kb2];
                pk[j] = ((ka <= q) ? va : 0u) | (((kb2 <= q) ? vb : 0u) << 16);
            }
        }
        unsigned lo = 1u, hi = 65536u; int c_lo = n, c_hi = 0;
        unsigned one2 = 0x00010001u; asm volatile("" : "+v"(one2));
        if (n > 256) {
            const u32x4 hw = *(const LAS u32x4*)(hist + qq * 256 + 4 * lane);
            int hb[8] = {(int)(hw.x & 0xffffu), (int)(hw.x >> 16), (int)(hw.y & 0xffffu), (int)(hw.y >> 16), (int)(hw.z & 0xffffu), (int)(hw.z >> 16), (int)(hw.w & 0xffffu), (int)(hw.w >> 16)};
            int tot = ((hb[0] + hb[1]) + (hb[2] + hb[3])) + ((hb[4] + hb[5]) + (hb[6] + hb[7]));
            int suf = tot;
#pragma unroll
            for (int d = 1; d < 64; d <<= 1) { const int o = __shfl_down(suf, d); suf += (lane + d < 64) ? o : 0; }
            int above = suf - tot;
            const bool mine_ = (suf >= 256) && (above < 256);
            int Bsel = 0, cl = 0, ch = 0;
#pragma unroll
            for (int i = 7; i >= 0; --i) { const int cge = above + hb[i]; if (above < 256 && cge >= 256) { Bsel = 8 * lane + i; cl = cge; ch = above; } above = cge; }
            const unsigned long long mb = __ballot(mine_);
            const int src = (int)__builtin_ctzll(mb);
            const int B = __builtin_amdgcn_readlane(Bsel, src); c_lo = __builtin_amdgcn_readlane(cl, src); c_hi = __builtin_amdgcn_readlane(ch, src);
            lo = (unsigned)B << 7; hi = lo + 128u; if (lo == 0u) lo = 1u;
        }
        if (n > 256 && c_lo != 256) {
            while (hi - lo > 1u) {
                const unsigned mid = (lo + hi) >> 1;
                const unsigned tm1 = (mid - 1u) * 0x00010001u;
                unsigned acc2 = 0u;
#pragma unroll
                for (int gq = 0; gq < 8; ++gq)
                    if (gq < ngrp) {
                        unsigned d0, d1, d2, d3;
                        asm("v_pk_sub_u16 %1, %5, %9 clamp\n\tv_pk_sub_u16 %2, %6, %9 clamp\n\tv_pk_sub_u16 %3, %7, %9 clamp\n\tv_pk_sub_u16 %4, %8, %9 clamp\n\t"
                            "v_pk_min_u16 %1, %1, %10\n\tv_pk_min_u16 %2, %2, %10\n\tv_pk_min_u16 %3, %3, %10\n\tv_pk_min_u16 %4, %4, %10\n\t"
                            "v_pk_add_u16 %1, %1, %2\n\tv_pk_add_u16 %3, %3, %4\n\tv_pk_add_u16 %0, %0, %1\n\tv_pk_add_u16 %0, %0, %3"
                            : "+v"(acc2), "=&v"(d0), "=&v"(d1), "=&v"(d2), "=&v"(d3)
                            : "v"(pk[4 * gq]), "v"(pk[4 * gq + 1]), "v"(pk[4 * gq + 2]), "v"(pk[4 * gq + 3]), "s"(tm1), "v"(one2));
                    }
                const int cc = wave_sum_i((int)((acc2 & 0xffffu) + (acc2 >> 16)));
                if (cc >= 256) { lo = mid; c_lo = cc; if (cc == 256) break; } else { hi = mid; c_hi = cc; }
            }
        }
        unsigned long long mine = 0ull;
        if (n <= 256 || c_lo == 256) {
#pragma unroll
            for (int j = 0; j < 32; ++j)
                if ((j >> 2) < ngrp) {
                    const unsigned long long ma = __ballot((pk[j] & 0xffffu) >= lo), mb = __ballot((pk[j] >> 16) >= lo);
                    mine = (lane == 2 * j) ? ma : mine; mine = (lane == 2 * j + 1) ? mb : mine;
                }
        } else {
            int need = 256 - c_hi;
            const unsigned long long lt = (1ull << lane) - 1ull;
#pragma unroll
            for (int j = 0; j < 32; ++j)
                if ((j >> 2) < ngrp) {
#pragma unroll
                    for (int hh = 0; hh < 2; ++hh) {
                        const unsigned kk = hh ? (pk[j] >> 16) : (pk[j] & 0xffffu);
                        const unsigned long long eq = __ballot(kk == lo);
                        const int rank = __popcll(eq & lt);
                        const bool sel = (kk > lo) || (kk == lo && rank < need);
                        need -= __popcll(eq); need = need < 0 ? 0 : need;
                        const unsigned long long mk = __ballot(sel); mine = (lane == 2 * j + hh) ? mk : mine;
                    }
                }
        }
        MASK[(size_t)(b * SEQ + q) * 64 + lane] = mine;
    }
    __syncthreads();
}
__device__ __forceinline__ void indexer_phase(Frame& F) {
    const int b = F.bx & 7, j = F.bx >> 3;
    if (F.G != 256) {
        for (int u = F.bx; u < NB * 256; u += F.G) indexer_unit(F, u >> 8, u & 255);
        return;
    }
    for (int k = 0; k < 4; ++k) { indexer_unit(F, b, 64 * k + j); indexer_unit(F, b, 64 * k + 63 - j); }
}

__device__ __forceinline__ int crow(int r, int hi) { return (r & 3) + 8 * (r >> 2) + 4 * hi; }
__device__ __forceinline__ s16x4 vtr(const LAS char* p) { typedef short v4i16_t __attribute__((ext_vector_type(4))); return __builtin_bit_cast(s16x4, __builtin_amdgcn_ds_read_tr16_b64_v4i16((LAS v4i16_t*)p)); }
__device__ __forceinline__ void glds16(const void* gsrc, unsigned lds_dst) { unsigned keep;
    asm volatile("s_mov_b32 %0, m0\n\ts_mov_b32 m0, %2\n\ts_nop 0\n\tglobal_load_lds_dwordx4 %1, off\n\ts_mov_b32 m0, %0" : "=&s"(keep) : "v"(gsrc), "s"(lds_dst) : "memory"); }
__device__ __forceinline__ void glds4(const void* gsrc, unsigned lds_dst) { unsigned keep;
    asm volatile("s_mov_b32 %0, m0\n\ts_mov_b32 m0, %2\n\ts_nop 0\n\tglobal_load_lds_dword %1, off\n\ts_mov_b32 m0, %0" : "=&s"(keep) : "v"(gsrc), "s"(lds_dst) : "memory"); }
__device__ __forceinline__ void attn_unit(Frame& F, int b, int h, int qb, float mfix) {
    const int lane = F.lane, wid = F.wave, r32 = lane & 31, hi = lane >> 5;
    const bf16_t* Q = WSP(bf16_t, WS_Q); const bf16_t* Kp = WSP(bf16_t, WS_K); const bf16_t* Vp = WSP(bf16_t, WS_V); bf16_t* MIX = WSP(bf16_t, WS_MIX);
    const unsigned long long* MASK = WSP(unsigned long long, WS_MASK);
    LAS unsigned char* lds = F.lds;
    const unsigned lds0 = (unsigned)(unsigned long)lds;
    const size_t rowbase = (size_t)b * SEQ; const int q0 = qb * 256, qw0 = q0 + wid * 32;
    const int NTL = (q0 + 256) / 64;
    const int myq = qw0 + r32;
    const bf16_t* Kh = Kp + rowbase * 512 + h * 64; const bf16_t* Vh = Vp + rowbase * 512 + h * 64;
    const bf16_t* ksrc = Kh + (size_t)lane * 512 + wid * 8;
    const bf16_t* vsrc = Vh + (size_t)(16 * (wid & 3) + (lane >> 2)) * 512 + (wid >> 2) * 32 + (lane & 3) * 8;
    const unsigned* msrc = (const unsigned*)(MASK + (rowbase + qw0 + (lane >> 1)) * 64) + (lane & 1);
    const unsigned kdst = lds0 + (unsigned)wid * 1024u, vdst = lds0 + 32768u + (unsigned)wid * 1024u, mdst = lds0 + 65536u + (unsigned)wid * 256u;
#define AT_DMA(t) do { const unsigned sl_ = (unsigned)((t) & 3); \
        glds16(ksrc + (size_t)(t) * 64 * 512, (unsigned)__builtin_amdgcn_readfirstlane(kdst + sl_ * 8192u)); \
        glds16(vsrc + (size_t)(t) * 64 * 512, (unsigned)__builtin_amdgcn_readfirstlane(vdst + sl_ * 8192u)); \
        glds4(msrc + (size_t)(t) * 2, (unsigned)__builtin_amdgcn_readfirstlane(mdst + sl_ * 2048u)); } while (0)
    bf16x8 qr[4];
    { const bf16_t* Qw = Q + (rowbase + myq) * 512 + h * 64;
#pragma unroll
      for (int d0 = 0; d0 < 4; ++d0) qr[d0] = *(const bf16x8*)(Qw + d0 * 16 + hi * 8); }
    asm volatile("" :: "v"(qr[0]), "v"(qr[1]), "v"(qr[2]), "v"(qr[3]));
    f32x16 o0 = {}, o1 = {}, osum = {};
    const bf16x8 ones8 = {0x3F80, 0x3F80, 0x3F80, 0x3F80, 0x3F80, 0x3F80, 0x3F80, 0x3F80};
    (void)mfix;
    const int lastq_tile = (qw0 + 31) >> 6;
    AT_DMA(0); AT_DMA(1); AT_DMA(2);
    for (int t = 0; t < NTL; ++t) {
        if (t + 2 < NTL) asm volatile("s_waitcnt vmcnt(6) lgkmcnt(0)\n\ts_barrier" ::: "memory");
        else if (t + 1 < NTL) asm volatile("s_waitcnt vmcnt(3) lgkmcnt(0)\n\ts_barrier" ::: "memory");
        else asm volatile("s_waitcnt vmcnt(0) lgkmcnt(0)\n\ts_barrier" ::: "memory");
        if (t + 3 < NTL) AT_DMA(t + 3);
        if (t <= lastq_tile) {
            const int sl = t & 3;
            const LAS char* kb = (const LAS char*)(lds + sl * 8192) + hi * 1024 + r32 * 16;
            const unsigned long long mcur = *(const LAS unsigned long long*)(lds + 65536 + sl * 2048 + wid * 256 + r32 * 8);
            f32x16 p0 = {}, p1 = {};
#pragma unroll
            for (int d0 = 0; d0 < 4; ++d0) {
                const bf16x8 k0 = *(const LAS bf16x8*)(kb + d0 * 2048), k1 = *(const LAS bf16x8*)(kb + d0 * 2048 + 512);
                p0 = __builtin_amdgcn_mfma_f32_32x32x16_bf16(k0, qr[d0], p0, 0, 0, 0);
                p1 = __builtin_amdgcn_mfma_f32_32x32x16_bf16(k1, qr[d0], p1, 0, 0, 0);
            }
            const unsigned m0 = (unsigned)(mcur) >> (4 * hi), m1 = (unsigned)(mcur >> 32) >> (4 * hi);
#pragma unroll
            for (int r = 0; r < 16; ++r) {
                const int bit = (r & 3) + 8 * (r >> 2);
                const float e0 = __builtin_amdgcn_exp2f(p0[r]), e1 = __builtin_amdgcn_exp2f(p1[r]);
                p0[r] = __int_as_float(__float_as_int(e0) & ((int)(m0 << (31 - bit)) >> 31)); p1[r] = __int_as_float(__float_as_int(e1) & ((int)(m1 << (31 - bit)) >> 31));
            }
            u32x4 pw[4];
#pragma unroll
            for (int ks = 0; ks < 4; ++ks) {
                const int bs = 8 * (ks & 1);
                if (ks < 2) pw[ks] = (u32x4){pk2(p0[bs], p0[bs + 1]), pk2(p0[bs + 2], p0[bs + 3]), pk2(p0[bs + 4], p0[bs + 5]), pk2(p0[bs + 6], p0[bs + 7])};
                else        pw[ks] = (u32x4){pk2(p1[bs], p1[bs + 1]), pk2(p1[bs + 2], p1[bs + 3]), pk2(p1[bs + 4], p1[bs + 5]), pk2(p1[bs + 6], p1[bs + 7])};
            }
            const LAS char* vb = (const LAS char*)(lds + 32768 + sl * 8192) + ((lane >> 4) & 1) * 32 + (lane & 3) * 8 + (4 * hi + ((lane & 15) >> 2)) * 64;
#pragma unroll
            for (int ks = 0; ks < 4; ++ks) {
                const s16x4 l0 = vtr(vb + ks * 1024), h0 = vtr(vb + ks * 1024 + 512), l1 = vtr(vb + 4096 + ks * 1024), h1 = vtr(vb + 4096 + ks * 1024 + 512);
                const bf16x8 v0 = (bf16x8){l0[0], l0[1], l0[2], l0[3], h0[0], h0[1], h0[2], h0[3]}, v1 = (bf16x8){l1[0], l1[1], l1[2], l1[3], h1[0], h1[1], h1[2], h1[3]};
                const bf16x8 pa = __builtin_bit_cast(bf16x8, pw[ks]);
                o0 = __builtin_amdgcn_mfma_f32_32x32x16_bf16(pa, v0, o0, 0, 0, 0);
                o1 = __builtin_amdgcn_mfma_f32_32x32x16_bf16(pa, v1, o1, 0, 0, 0);
                osum = __builtin_amdgcn_mfma_f32_32x32x16_bf16(pa, ones8, osum, 0, 0, 0);
            }
        }
    }
    bf16_t* Ow = MIX + (rowbase + qw0) * 1024 + 512 + h * 64;
#pragma unroll
    for (int r = 0; r < 16; ++r) {
        const int qrow = crow(r, hi);
        const float li = 1.0f / osum[r];
        Ow[(size_t)qrow * 1024 + r32] = (bf16_t)(pk2(o0[r] * li, 0.f) & 0xffffu);
        Ow[(size_t)qrow * 1024 + 32 + r32] = (bf16_t)(pk2(o1[r] * li, 0.f) & 0xffffu);
    }
    asm volatile("s_waitcnt lgkmcnt(0)\n\ts_barrier" ::: "memory");
#undef AT_DMA
}
__device__ __forceinline__ void attn_phase(Frame& F, ArgsP ap) {
    float mg = fabsf(ap->q_g[F.lane]), mk = fabsf(ap->k_g[F.lane]);
    mg = wave_max(mg); mk = wave_max(mk);
    const float mfix = 8.0f * mg * mk * LOG2E + 0.125f;
    if (F.G == 256) {
        const int vcu = (F.bx % 8) * 32 + F.bx / 8, bh = vcu >> 2, s = vcu & 3;
        const int qbs[4] = {s, 7 - s, 8 + s, 15 - s};
#pragma unroll
        for (int i = 0; i < 4; ++i) attn_unit(F, bh >> 3, bh & 7, qbs[i], mfix);
    } else {
        for (int u = F.bx; u < 1024; u += F.G) attn_unit(F, u >> 7, (u >> 4) & 7, u & 15, mfix);
    }
}

__device__ __forceinline__ void route_phase(Frame& F, ArgsP ap) {
    const float* router_bias = ap->router_bias;
    volatile LAS unsigned* lcnt = F.MISC + MW_LCNT; volatile LAS unsigned* lbase = F.MISC + MW_BASE;
    const float* LOGI = WSP(float, WS_LOG); int* PAIR = WSP(int, WS_PAIR); float* GATE = WSP(float, WS_GATE); int* INV = WSP(int, WS_INV);
    unsigned* gcnt = (unsigned*)(F.ws + WS_CTL) + CW_CNT;
    for (int blk = F.bx; blk < NTOK / 128; blk += F.G) {
        if (F.tid < 64) lcnt[F.tid] = 0u;
        __syncthreads();
        int ei[8]; float gi[8]; unsigned lp[8];
        const int t = blk * 128 + F.tid;
        if (F.tid < 128) {
            float sc[64], sel[64];
#pragma unroll
            for (int j = 0; j < 16; ++j) { const f32x4 v = ((const f32x4*)(LOGI + (size_t)t * 64))[j];
#pragma unroll
                for (int e = 0; e < 4; ++e) { const float s = 1.0f / (1.0f + __expf(-v[e])); sc[4 * j + e] = s; sel[4 * j + e] = s + router_bias[4 * j + e]; } }
            float gs = 0.f;
#pragma unroll
            for (int k = 0; k < 8; ++k) {
                float best = -INFINITY, bs = 0.f; int bi = 0;
#pragma unroll
                for (int e = 0; e < 64; ++e) { const bool gt = sel[e] > best; best = gt ? sel[e] : best; bs = gt ? sc[e] : bs; bi = gt ? e : bi; }
#pragma unroll
                for (int e = 0; e < 64; ++e) sel[e] = (e == bi) ? -INFINITY : sel[e];
                ei[k] = bi; gi[k] = bs; gs += bs;
            }
            const float gn = 2.5f / gs;
#pragma unroll
            for (int k = 0; k < 8; ++k) { gi[k] *= gn; lp[k] = __hip_atomic_fetch_add((LAS unsigned*)&lcnt[ei[k]], 1u, __ATOMIC_RELAXED, __HIP_MEMORY_SCOPE_WORKGROUP); }
        }
        __syncthreads();
        if (F.tid < 64) lbase[F.tid] = __hip_atomic_fetch_add(gcnt + F.tid, lcnt[F.tid], __ATOMIC_RELAXED, __HIP_MEMORY_SCOPE_AGENT);
        __syncthreads();
        if (F.tid < 128) {
#pragma unroll
            for (int k = 0; k < 8; ++k) { const int idx = ei[k] * PAIRCAP + (int)(lbase[ei[k]] + lp[k]); PAIR[idx] = t * 8 + k; INV[t * 8 + k] = idx; GATE[t * 8 + k] = gi[k]; }
        }
        __syncthreads();
    }
}
__device__ __forceinline__ void load_expert_tables(Frame& F) {
    volatile LAS int* tp = (volatile LAS int*)(F.MISC + MW_TP); volatile LAS int* cnt = (volatile LAS int*)(F.MISC + MW_CNT);
    unsigned* gcnt = (unsigned*)(F.ws + WS_CTL) + CW_CNT;
    if (F.tid < 64) cnt[F.tid] = (int)__hip_atomic_load(gcnt + F.tid, __ATOMIC_RELAXED, __HIP_MEMORY_SCOPE_AGENT);
    __syncthreads();
    if (F.tid == 0) { int s = SH_TILES; for (int e = 0; e < 64; ++e) { tp[e] = s; s += (cnt[e] + 255) >> 8; } tp[64] = s;
        volatile LAS int* tpx = (volatile LAS int*)(F.MISC + MW_TPX); const int x = F.bx & 7; int sx = 0;
        for (int k = 0; k < 8; ++k) { tpx[k] = sx; sx += (cnt[x + 8 * k] + 255) >> 8; } tpx[8] = sx; }
    __syncthreads();
}

__global__ void __launch_bounds__(NTHR, 2) hymba_fwd(Args args) {
    extern __shared__ __attribute__((aligned(16))) unsigned char lds_raw[];
    Frame F;
    F.lds = (LAS unsigned char*)lds_raw; F.MISC = (volatile LAS unsigned*)(F.lds + MISC_OFF);
    F.G = gridDim.x;
    ArgsP ap = refresh(F);
    for (int u = F.tid; u < MISC_BYTES / 4; u += NTHR) F.MISC[u] = 0u;
    __syncthreads();
    XcdBarrier bar = xcd_barrier_post((unsigned*)(F.ws + WS_CTL) + CW_BAR, F.MISC + 8);
#define GRID_BAR() do { xcd_barrier(bar); ap = refresh(F); } while (0)
#ifndef PH_MASK
#define PH_MASK 0xFFFF
#endif
#define PH(k) ((PH_MASK >> (k)) & 1)
#ifndef REP_K
#define REP_K -1
#endif
#define RUN(k, ...) do { __VA_ARGS__; if ((k) == REP_K) { ap = refresh(F); __VA_ARGS__; } } while (0)
    RUN(0, phase0a(F, ap));
    GRID_BAR();
    if (REP_K == 20) { for (int _r = 0; _r < 20; ++_r) GRID_BAR(); }
    RUN(1, modnorm_rows(F, ap->x, ap->norm1_g, 0, WSP(bf16_t, WS_XN)));
    GRID_BAR();
    RUN(2, {
        PolIn P; P.A = (const char*)(F.ws + WS_XN); P.Bt = (const char*)(F.ws + WS_BTIN); P.so.init(NTOK, NIN, F.G, F.bx);
        P.U = WSP(bf16_t, WS_U); P.BG = WSP(bf16_t, WS_BG); P.Q = WSP(bf16_t, WS_Q); P.Kk = WSP(bf16_t, WS_K); P.V = WSP(bf16_t, WS_V); P.QI = WSP(bf16_t, WS_QI); P.KI = WSP(bf16_t, WS_KI);
        P.WI = WSP(float, WS_WI); P.rope = WSP(float, WS_ROPE); P.gq = ap->q_g; P.gk = ap->k_g; P.gki = ap->ki_g;
        g8::gemm_run(F.lds, F.tid, P);
        ap = refresh(F); if (F.bx >= 128) static_jobs13(F, ap, (F.bx - 128) * 8 + F.wave, 1024, 0, NJ13_P1);
    });
    GRID_BAR();
    RUN(3, conv_phase(F, ap));
    RUN(4, indexer_phase(F));
    GRID_BAR();
    RUN(5, attn_phase(F, ap));
    GRID_BAR();
    RUN(6, {
        PolOut P; P.A = (const char*)(F.ws + WS_MIX); P.Bt = (const char*)(F.ws + WS_BTOUT); P.so.init(NTOK, DM, F.G, F.bx); P.x = ap->x; P.ada = WSP(float, WS_ADA); P.out = ap->out;
        g8::gemm_run(F.lds, F.tid, P);
    });
    GRID_BAR();
    RUN(7, modnorm_rows_bf16(F, (const bf16_t*)(ap->out + (size_t)NTOK * DM / 2), ap->norm2_g, 3072, WSP(bf16_t, WS_XN)));
    GRID_BAR();
    RUN(8, {
        PolS P; P.A = (const char*)(F.ws + WS_XN); P.W13s = (const char*)(F.ws + WS_W13) + (size_t)64 * 512 * 2048; P.Wr = (const char*)(F.ws + WS_WRT); P.G = F.G; P.c = (F.bx & 7) * (F.G >> 3) + (F.bx >> 3);
        P.HIDS = WSP(bf16_t, WS_HID); P.LOGI = WSP(float, WS_LOG);
        g8::gemm_run(F.lds, F.tid, P);
        ap = refresh(F); if ((F.bx & 7) >= 4) static_jobs13(F, ap, (((F.bx & 7) - 4) * 32 + (F.bx >> 3)) * 8 + F.wave, 1024, NJ13_P1, NJ13);
    });
    GRID_BAR();
    if (PH(9)) route_phase(F, ap);
    GRID_BAR();
    load_expert_tables(F);
    RUN(10, {
        PolG1 P; P.A = (const char*)(F.ws + WS_XN); P.W13 = (const char*)(F.ws + WS_W13); P.PAIR = WSP(int, WS_PAIR); P.HID = WSP(bf16_t, WS_HID); P.G = F.G; P.c = F.bx;
        P.tp = (const volatile LAS int*)(F.MISC + MW_TP); P.cnt = (const volatile LAS int*)(F.MISC + MW_CNT); P.tpx = (const volatile LAS int*)(F.MISC + MW_TPX);
        g8::gemm_run(F.lds, F.tid, P);
        ap = refresh(F); drain_jobs2(F, ap, CW_JOB + 128, NJ2);
    });
    GRID_BAR();
    RUN(11, {
        PolG2 P; P.A = (const char*)(F.ws + WS_HID); P.W2 = (const char*)(F.ws + WS_W2); P.Y = WSP(unsigned char, WS_Y);
        P.G = F.G; P.c = F.bx; P.tp = (const volatile LAS int*)(F.MISC + MW_TP); P.tpx = (const volatile LAS int*)(F.MISC + MW_TPX);
        g8::gemm_run(F.lds, F.tid, P);
    });
    GRID_BAR();
    if (PH(12)) combine_phase(F, ap->out, [&]() { GRID_BAR(); });
}

extern "C" void kernel_launch(void* const* d_in, const int* in_sizes, int n_in, void* d_out, int out_size, void* d_ws, size_t ws_size, hipStream_t stream) {
    static int grid = 0;
    if (grid == 0) {
        if (n_in != 21 || out_size != NTOK * DM || ws_size < WS_END) { fprintf(stderr, "kernel_launch: unexpected problem (n_in %d, out %d, ws %zu)\n", n_in, out_size, ws_size); grid = -1; return; }
        int dev = 0, cus = 0;
        if (hipGetDevice(&dev) != hipSuccess || hipDeviceGetAttribute(&cus, hipDeviceAttributeMultiprocessorCount, dev) != hipSuccess) { grid = -1; return; }
        if (hipFuncSetAttribute((const void*)hymba_fwd, hipFuncAttributeMaxDynamicSharedMemorySize, LDS_BYTES) != hipSuccess) { fprintf(stderr, "kernel_launch: hipFuncSetAttribute failed\n"); grid = -1; return; }
        int per_cu = 0;
        if (hipOccupancyMaxActiveBlocksPerMultiprocessor(&per_cu, (const void*)hymba_fwd, NTHR, LDS_BYTES) != hipSuccess || per_cu < 1) fprintf(stderr, "kernel_launch: occupancy query says %d\n", per_cu);
        (void)hipGetLastError();
        if (cus != 256) { fprintf(stderr, "kernel_launch: built for a 256-CU device (got %d)\n", cus); grid = -1; return; }
        grid = cus;
    }
    if (grid < 0) return;
    (void)hipMemsetAsync((char*)d_ws + WS_CTL, 0, CTL_ZERO_BYTES, stream);
    Args a{};
    a.x = (const float*)d_in[0]; a.c = (const float*)d_in[1]; a.pos = (const int*)d_in[2]; a.norm1_g = (const float*)d_in[3]; a.norm2_g = (const float*)d_in[4];
    a.w_ada = (const float*)d_in[5]; a.b_ada = (const float*)d_in[6]; a.w_in = (const float*)d_in[7]; a.conv_w = (const float*)d_in[8]; a.q_g = (const float*)d_in[9];
    a.k_g = (const float*)d_in[10]; a.ki_g = (const float*)d_in[11]; a.w_out = (const float*)d_in[12]; a.w_router = (const float*)d_in[13]; a.router_bias = (const float*)d_in[14];
    a.w1 = (const float*)d_in[15]; a.w3 = (const float*)d_in[16]; a.w2 = (const float*)d_in[17]; a.ws1 = (const float*)d_in[18]; a.ws3 = (const float*)d_in[19]; a.ws2 = (const float*)d_in[20];
    a.out = (float*)d_out; a.ws = (unsigned char*)d_ws;
    hipLaunchKernelGGL(hymba_fwd, dim3(grid), dim3(NTHR), LDS_BYTES, stream, a);
}
```
